# Optimizing an MI355X kernel written in HIP

```python
import math
import jax, jax.numpy as jnp
from jax import lax
import numpy as np

D_MODEL = 1024
BATCH = 8
SEQ = 8192
DEPTH = 1
DEC_BATCH = 8
DEC_SEQ = 64
PAST_LEN = 1024

CHUNK = 64
Q_BLOCK = 128
D_MIX = 2 * D_MODEL
A_WIDTH = D_MIX // 2
B_WIDTH = D_MIX - A_WIDTH
A_V_DIM = 128
A_HEADS = A_WIDTH // A_V_DIM
A_QK_DIM = A_V_DIM // 2
ROT_DIM = A_QK_DIM // 4
ROPE_THETA = 500000.0
B_HEAD_DIM = 64
B_HEADS = B_WIDTH // B_HEAD_DIM
W_RANK = 64
A_RANK = 64
NORM_EPS = 1e-6
SUBLN_EPS = 1e-5
GN_EPS = 64e-5

A_Q = 0
A_K = A_Q + A_WIDTH
A_V = A_K + A_WIDTH
A_G = A_V + A_WIDTH
B_R = A_G + A_WIDTH
B_K = B_R + B_WIDTH
B_V = B_K + B_WIDTH
B_WD = B_V + B_WIDTH
B_AD = B_WD + W_RANK
B_G = B_AD + A_RANK
IN_TOTAL = B_G + B_WIDTH
SHIFT_W = B_G - B_R

kernel_name = 'hybrid_diffattn_rwkv7_stream_step'

F32 = jnp.float32


def _rms_norm(x, g, eps):
    xf = x.astype(F32)
    y = xf * lax.rsqrt(jnp.mean(xf * xf, axis=-1, keepdims=True) + eps)
    return (y * g.astype(F32)).astype(x.dtype)


def _partial_rope(x, pos):
    half = ROT_DIM // 2
    inv = jnp.power(jnp.float32(ROPE_THETA), -jnp.arange(half, dtype=F32) * (2.0 / ROT_DIM))
    ang = pos.astype(F32)[:, None] * inv[None, :]
    cos = jnp.cos(ang)[None, :, None, None, :]
    sin = jnp.sin(ang)[None, :, None, None, :]
    xf = x.astype(F32)
    x1 = xf[..., :half]
    x2 = xf[..., half:ROT_DIM]
    out = jnp.concatenate([x1 * cos - x2 * sin, x2 * cos + x1 * sin, xf[..., ROT_DIM:]], axis=-1)
    return out.astype(x.dtype)


def _diff_attend(q, k, v, q_pos, k_pos, lam):
    s = jnp.einsum('bqhcd,bkhcd->bchqk', q, k).astype(F32) * (A_QK_DIM ** -0.5)
    visible = (k_pos[None, :] // CHUNK) <= (q_pos[:, None] // CHUNK)
    s = jnp.where(visible[None, None, None], s, -jnp.inf)
    p = jax.nn.softmax(s, axis=-1)
    wgt = p[:, 0] - lam * p[:, 1]
    return jnp.einsum('bhqk,bkhd->bqhd', wgt.astype(v.dtype), v)


def _wkv_scan(r, w, k, v, a, b, s0):
    def step(s, inp):
        r_t, w_t, k_t, v_t, a_t, b_t = inp
        sa = jnp.einsum('bhij,bhj->bhi', s, a_t)
        s = s * w_t[:, :, None, :] + sa[..., None] * b_t[:, :, None, :] + v_t[..., None] * k_t[:, :, None, :]
        return s, jnp.einsum('bhij,bhj->bhi', s, r_t)
    xs = tuple(jnp.moveaxis(t, 1, 0) for t in (r, w, k, v, a, b))
    s_T, ys = lax.scan(step, s0, xs)
    return jnp.moveaxis(ys, 0, 1), s_T


def _layer(x, pos, past_k, past_v, past_pos, wkv0, shift0, lw, lambda_init):
    (norm_pre, w_in, lam_q1, lam_k1, lam_q2, lam_k2, subln, mu_shift, w0, w_up, a0, a_up,
     k_k, k_a, r_k, ln_x_w, ln_x_b, w_out, norm_post) = lw
    bsz, t_len, _ = x.shape
    h = _rms_norm(x, norm_pre, NORM_EPS)
    proj = h @ w_in

    q = _partial_rope(proj[..., A_Q:A_K].reshape(bsz, t_len, A_HEADS, 2, A_QK_DIM), pos)
    k = _partial_rope(proj[..., A_K:A_V].reshape(bsz, t_len, A_HEADS, 2, A_QK_DIM), pos)
    v = proj[..., A_V:A_G].reshape(bsz, t_len, A_HEADS, A_V_DIM)
    lam = (jnp.exp(jnp.sum(lam_q1.astype(F32) * lam_k1.astype(F32)))
           - jnp.exp(jnp.sum(lam_q2.astype(F32) * lam_k2.astype(F32))) + lambda_init)
    if past_k is None:
        nblk = t_len // Q_BLOCK
        qb = jnp.moveaxis(q.reshape(bsz, nblk, Q_BLOCK, A_HEADS, 2, A_QK_DIM), 1, 0)
        pb = pos.reshape(nblk, Q_BLOCK)
        o = lax.map(lambda qp: _diff_attend(qp[0], k, v, qp[1], pos, lam), (qb, pb))
        o = jnp.moveaxis(o, 0, 1).reshape(bsz, t_len, A_HEADS, A_V_DIM)
    else:
        k_all = jnp.concatenate([past_k.astype(k.dtype), k], axis=1)
        v_all = jnp.concatenate([past_v.astype(v.dtype), v], axis=1)
        k_pos = jnp.concatenate([past_pos, pos])
        o = _diff_attend(q, k_all, v_all, pos, k_pos, lam)
    o = _rms_norm(o, subln, SUBLN_EPS).astype(F32) * (1.0 - lambda_init)
    y_a = o.reshape(bsz, t_len, A_WIDTH) * jax.nn.silu(proj[..., A_G:B_R].astype(F32))

    ps = proj[..., B_R:B_G]
    prev = jnp.concatenate([shift0.astype(ps.dtype), ps[:, :-1]], axis=1)
    m = (ps + (prev - ps) * mu_shift).astype(F32)
    r = m[..., 0:B_WIDTH]
    kb = m[..., B_WIDTH:2 * B_WIDTH]
    vb = m[..., 2 * B_WIDTH:3 * B_WIDTH]
    wd = m[..., 3 * B_WIDTH:3 * B_WIDTH + W_RANK]
    ad = m[..., 3 * B_WIDTH + W_RANK:]
    w_log = -jax.nn.softplus(-(w0.astype(F32) + jnp.tanh(wd) @ w_up.astype(F32))) - 0.5
    decay = jnp.exp(-jnp.exp(w_log))
    a = jax.nn.sigmoid(a0.astype(F32) + ad @ a_up.astype(F32))
    hs = lambda t: t.reshape(bsz, t_len, B_HEADS, B_HEAD_DIM)
    kk = hs(kb * k_k.astype(F32))
    kk = kk / jnp.maximum(jnp.sqrt(jnp.sum(kk * kk, axis=-1, keepdims=True)), 1e-12)
    kb = kb * (1.0 + (a - 1.0) * k_a.astype(F32))
    rh, kh, vh, ah = hs(r), hs(kb), hs(vb), hs(a)
    yb, s_T = _wkv_scan(rh, hs(decay), kh, vh, -kk, kk * ah, wkv0.astype(F32))
    mean = jnp.mean(yb, axis=-1, keepdims=True)
    var = jnp.mean(jnp.square(yb - mean), axis=-1, keepdims=True)
    yb = ((yb - mean) * lax.rsqrt(var + GN_EPS)).reshape(bsz, t_len, B_WIDTH)
    yb = yb * ln_x_w.astype(F32) + ln_x_b.astype(F32)
    bonus = jnp.sum(rh * kh * r_k.astype(F32), axis=-1, keepdims=True) * vh
    yb = (yb + bonus.reshape(bsz, t_len, B_WIDTH)) * jax.nn.silu(proj[..., B_G:IN_TOTAL].astype(F32))

    mix = jnp.concatenate([y_a, yb], axis=-1).astype(x.dtype)
    out = mix @ w_out
    x_new = x + _rms_norm(out, norm_post, NORM_EPS)
    return x_new, k, v, s_T.astype(x.dtype), ps[:, -1:]


def setup_inputs(seed: int = 0) -> dict:
    key = jax.random.key(seed)
    ks = jax.random.split(key, 32)
    L = DEPTH
    nrm = lambda k, shape, scale: jax.random.normal(k, shape, F32) * scale
    return {
        'x_prompt': nrm(ks[0], (BATCH, SEQ, D_MODEL), 1.0),
        'x_sample': nrm(ks[1], (DEC_BATCH, DEC_SEQ, D_MODEL), 1.0),
        'cache_k': nrm(ks[2], (L, DEC_BATCH, PAST_LEN, A_HEADS, 2, A_QK_DIM), 1.0),
        'cache_v': nrm(ks[3], (L, DEC_BATCH, PAST_LEN, A_HEADS, A_V_DIM), 1.0),
        'state_wkv': nrm(ks[4], (L, DEC_BATCH, B_HEADS, B_HEAD_DIM, B_HEAD_DIM), 0.3),
        'state_shift': nrm(ks[5], (L, DEC_BATCH, 1, SHIFT_W), 1.0),
        'norm_pre': 1.0 + nrm(ks[6], (L, D_MODEL), 0.05),
        'w_in': nrm(ks[7], (L, D_MODEL, IN_TOTAL), D_MODEL ** -0.5),
        'lam_q1': nrm(ks[8], (L, A_QK_DIM), 0.1),
        'lam_k1': nrm(ks[9], (L, A_QK_DIM), 0.1),
        'lam_q2': nrm(ks[10], (L, A_QK_DIM), 0.1),
        'lam_k2': nrm(ks[11], (L, A_QK_DIM), 0.1),
        'subln': 1.0 + nrm(ks[12], (L, A_V_DIM), 0.05),
        'mu_shift': jax.random.uniform(ks[13], (L, SHIFT_W), F32, 0.0, 1.0),
        'w0': jax.random.uniform(ks[14], (L, B_WIDTH), F32, -2.0, 2.0),
        'w_up': nrm(ks[15], (L, W_RANK, B_WIDTH), 0.1 * W_RANK ** -0.5),
        'a0': nrm(ks[16], (L, B_WIDTH), 0.1),
        'a_up': nrm(ks[17], (L, A_RANK, B_WIDTH), 0.5 * A_RANK ** -0.5),
        'k_k': 0.85 + nrm(ks[18], (L, B_WIDTH), 0.05),
        'k_a': 1.0 + nrm(ks[19], (L, B_WIDTH), 0.05),
        'r_k': nrm(ks[20], (L, B_HEADS, B_HEAD_DIM), 0.1),
        'ln_x_w': 1.0 + nrm(ks[21], (L, B_WIDTH), 0.05),
        'ln_x_b': nrm(ks[22], (L, B_WIDTH), 0.02),
        'w_out': nrm(ks[23], (L, D_MIX, D_MODEL), D_MIX ** -0.5),
        'norm_post': 1.0 + nrm(ks[24], (L, D_MODEL), 0.05),
    }


def reference(x_prompt, x_sample, cache_k, cache_v, state_wkv, state_shift, norm_pre, w_in,
              lam_q1, lam_k1, lam_q2, lam_k2, subln, mu_shift, w0, w_up, a0, a_up, k_k, k_a,
              r_k, ln_x_w, ln_x_b, w_out, norm_post):
    b_p, t_p, _ = x_prompt.shape
    b_s, t_s, _ = x_sample.shape
    past_len = cache_k.shape[2]
    pos_p = jnp.arange(t_p, dtype=jnp.int32)
    pos_s = past_len + jnp.arange(t_s, dtype=jnp.int32)
    past_pos = jnp.arange(past_len, dtype=jnp.int32)
    xp, xs = x_prompt, x_sample
    kp_l, vp_l, wp_l, sp_l = [], [], [], []
    ks_l, vs_l, ws_l, ss_l = [], [], [], []
    for l in range(DEPTH):
        lambda_init = 0.8 - 0.6 * math.exp(-0.3 * l)
        lw = (norm_pre[l], w_in[l], lam_q1[l], lam_k1[l], lam_q2[l], lam_k2[l], subln[l],
              mu_shift[l], w0[l], w_up[l], a0[l], a_up[l], k_k[l], k_a[l], r_k[l],
              ln_x_w[l], ln_x_b[l], w_out[l], norm_post[l])
        wkv_zero = jnp.zeros((b_p, B_HEADS, B_HEAD_DIM, B_HEAD_DIM), F32)
        shift_zero = jnp.zeros((b_p, 1, SHIFT_W), xp.dtype)
        xp, kp, vp, wp, sp = _layer(xp, pos_p, None, None, None, wkv_zero, shift_zero, lw, lambda_init)
        xs, k_s, v_s, w_s, s_s = _layer(xs, pos_s, cache_k[l], cache_v[l], past_pos,
                                       state_wkv[l], state_shift[l], lw, lambda_init)
        kp_l.append(kp); vp_l.append(vp); wp_l.append(wp); sp_l.append(sp)
        ks_l.append(k_s); vs_l.append(v_s); ws_l.append(w_s.astype(state_wkv.dtype)); ss_l.append(s_s)
    return (xp, xs,
            jnp.stack(kp_l), jnp.stack(vp_l), jnp.stack(wp_l), jnp.stack(sp_l),
            jnp.stack(ks_l), jnp.stack(vs_l), jnp.stack(ws_l), jnp.stack(ss_l))
```

```cpp
#include <hip/hip_runtime.h>
#include <hip/hip_cooperative_groups.h>
#include <stdint.h>
#include <stdio.h>
namespace cg = cooperative_groups;

#ifndef NLAUNCH
#define NLAUNCH 1
#endif

typedef unsigned short u16;
typedef unsigned int u32;
using bf16x8 = __attribute__((ext_vector_type(8))) short;
using f32x4 = __attribute__((ext_vector_type(4))) float;
using f32x16 = __attribute__((ext_vector_type(16))) float;
using u32x4 = __attribute__((ext_vector_type(4))) unsigned;
using u32x2 = __attribute__((ext_vector_type(2))) unsigned;

#define DI __device__ __forceinline__
#define LAUNDER_TID(t) int t = (g_wave << 6) | (int)__builtin_amdgcn_mbcnt_hi(~0u, __builtin_amdgcn_mbcnt_lo(~0u, 0u)); asm volatile("" : "+v"(t))

constexpr int TP = 65536, TS = 512, TT = 66048;
constexpr int NINP = 8448;
constexpr int LDS_BYTES = 157696;

constexpr size_t WS_CTR = 0;
constexpr size_t WS_ROPE = 4096;
constexpr size_t WS_WINT = WS_ROPE + 8192 * 16 * 4;
constexpr size_t WS_WOUTT = WS_WINT + (size_t)NINP * 1024 * 2;
constexpr size_t WS_WUPT = WS_WOUTT + (size_t)1024 * 2048 * 2;
constexpr size_t WS_AUPT = WS_WUPT + 1024 * 64 * 2;
constexpr size_t WS_H = WS_AUPT + 1024 * 64 * 2;
constexpr size_t WS_Q = WS_H + (size_t)TT * 1024 * 2;
constexpr size_t WS_K = WS_Q + (size_t)TT * 1024 * 2;
constexpr size_t WS_KC = WS_K + (size_t)TP * 1024 * 2;
constexpr size_t WS_VT = WS_KC + (size_t)8 * 1088 * 1024 * 2;
constexpr size_t WS_VTS = WS_VT + (size_t)TP * 1024 * 2;
constexpr size_t WS_PS = WS_VTS + (size_t)8 * 1088 * 1024 * 2;
constexpr size_t WS_END = WS_PS + (size_t)TT * 3200 * 2;
constexpr size_t WS_TOTAL = WS_END + (size_t)256 * 8 * 16384;

constexpr size_t O_Y = 0;
constexpr size_t O_KP = (size_t)TT * 1024;
constexpr size_t O_VP = O_KP + (size_t)TP * 1024;
constexpr size_t O_WKVP = O_VP + (size_t)TP * 1024;
constexpr size_t O_SHP = O_WKVP + 524288;
constexpr size_t O_KS = O_SHP + 25600;
constexpr size_t O_VS = O_KS + 524288;
constexpr size_t O_WKVS = O_VS + 524288;
constexpr size_t O_SHS = O_WKVS + 524288;

struct Params {
  const float *x_prompt, *x_sample, *cache_k, *cache_v, *state_wkv, *state_shift, *norm_pre, *w_in,
      *lq1, *lk1, *lq2, *lk2, *subln, *mu, *w0, *w_up, *a0, *a_up, *k_k, *k_a, *r_k, *ln_w, *ln_b, *w_out, *norm_post;
  float* out;
  char* ws;
  long ph_lo, ph_hi;
};

DI u16 f2bf(float f) { u32 u = __float_as_uint(f); u += 0x7fffu + ((u >> 16) & 1u); return (u16)(u >> 16); }
DI float bf2f(u16 h) { return __uint_as_float(((u32)h) << 16); }
DI u32 cvtpk(float lo, float hi) { u32 r; asm volatile("v_cvt_pk_bf16_f32 %0, %1, %2" : "=v"(r) : "v"(lo), "v"(hi)); return r; }
DI float wave_sum(float v) { for (int o = 32; o > 0; o >>= 1) v += __shfl_xor(v, o); return v; }
DI float dppf(float x, const int ctrl) { return x; }
#define DPP_ADD(x, ctrl) ((x) + __int_as_float(__builtin_amdgcn_mov_dpp(__float_as_int(x), (ctrl), 0xf, 0xf, true)))
DI float silu(float x) { return x * __builtin_amdgcn_rcpf(1.f + __expf(-x)); }

DI void transpose_tile(const float* src, long sld, u16* dst, long dld, int r0, int c0, float* t, const int g_wave) {
  LAUNDER_TID(tid);
  int a = tid >> 6, l = tid & 63;
  for (int i = 0; i < 8; ++i) t[(a + 8 * i) * 65 + l] = src[(long)(r0 + a + 8 * i) * sld + c0 + l];
  __syncthreads();
  for (int i = 0; i < 8; ++i) dst[(long)(c0 + a + 8 * i) * dld + r0 + l] = f2bf(t[l * 65 + a + 8 * i]);
  __syncthreads();
}

DI void phase0(const Params& p, char* smem, const int g_wave) {
  LAUNDER_TID(tid);
  const int lane = tid & 63, wid = tid >> 6;
  const int gw = blockIdx.x * 8 + wid, nw = gridDim.x * 8;
  const long gt = (long)blockIdx.x * 512 + tid, nt = (long)gridDim.x * 512;
  if (blockIdx.x == 0 && tid == 0) { ((int*)(p.ws + WS_CTR))[0] = 0; }
  {
    float* rope = (float*)(p.ws + WS_ROPE);
    const double invf[8] = {1.0, 0.19392274474868576, 0.03760603093086393, 0.007292664737217109,
                            0.001414213562373095, 0.0002742481756762073, 5.318295896944988e-05, 1.031338537721246e-05};
    for (long i = gt; i < 8192 * 8; i += nt) {
      int pos = (int)(i >> 3), k = (int)(i & 7);
      double iv = k == 0 ? invf[0] : k == 1 ? invf[1] : k == 2 ? invf[2] : k == 3 ? invf[3] : k == 4 ? invf[4] : k == 5 ? invf[5] : k == 6 ? invf[6] : invf[7];
      double x = (double)pos * iv;
      double n = rint(x * 0.15915494309189535);
      double rr = fma(-n, 6.283185307179586, x);
      rr = fma(-n, 2.4492935982947064e-16, rr);
      double x2 = rr * rr;
      double c = 1.0, s = 1.0, tc = 1.0, ts = 1.0;
      for (int m = 1; m <= 14; ++m) {
        tc *= -x2 / (double)((2 * m - 1) * (2 * m));
        ts *= -x2 / (double)((2 * m) * (2 * m + 1));
        c += tc; s += ts;
      }
      s *= rr;
      rope[pos * 16 + k] = (float)c;
      rope[pos * 16 + 8 + k] = (float)s;
    }
  }
  {
    u16* H = (u16*)(p.ws + WS_H);
    for (int row = gw; row < TT; row += nw) {
      const float* x = row < TP ? p.x_prompt + (size_t)row * 1024 : p.x_sample + (size_t)(row - TP) * 1024;
      float4 v[4]; float ss = 0.f;
      for (int i = 0; i < 4; ++i) { v[i] = ((const float4*)x)[lane + 64 * i]; ss += v[i].x * v[i].x + v[i].y * v[i].y + v[i].z * v[i].z + v[i].w * v[i].w; }
      ss = wave_sum(ss);
      float sc = rsqrtf(ss * (1.f / 1024.f) + 1e-6f);
      for (int i = 0; i < 4; ++i) {
        float4 g = ((const float4*)p.norm_pre)[lane + 64 * i];
        u32x2 o; o[0] = cvtpk(v[i].x * sc * g.x, v[i].y * sc * g.y); o[1] = cvtpk(v[i].z * sc * g.z, v[i].w * sc * g.w);
        *(u32x2*)(H + (size_t)row * 1024 + (lane + 64 * i) * 4) = o;
      }
    }
  }
  {
    u16* KC = (u16*)(p.ws + WS_KC);
    for (long i = gt; i < (long)8 * 1024 * 256; i += nt) {
      long e = i * 4; int b = (int)(e >> 20); long rem = e & 1048575;
      float4 v = ((const float4*)p.cache_k)[i];
      u32x2 o; o[0] = cvtpk(v.x, v.y); o[1] = cvtpk(v.z, v.w);
      *(u32x2*)(KC + (size_t)b * 1088 * 1024 + rem) = o;
    }
  }
  {
    u32* Z = (u32*)(p.ws + WS_WINT + (size_t)8320 * 1024 * 2);
    for (long i = gt; i < 128 * 1024 / 2; i += nt) Z[i] = 0u;
  }
  {
    float* t = (float*)smem;
    const int n0 = 16 * 130, n1 = n0 + 32 * 16, n2 = n1 + 16, n3 = n2 + 16, n4 = n3 + 64 * 32;
    for (int j = blockIdx.x; j < n4; j += gridDim.x) {
      if (j < n0) { int rt = j / 130, ct = j % 130; transpose_tile(p.w_in, 8320, (u16*)(p.ws + WS_WINT), 1024, rt * 64, ct * 64, t, g_wave); }
      else if (j < n1) { int q = j - n0; transpose_tile(p.w_out, 1024, (u16*)(p.ws + WS_WOUTT), 2048, (q >> 4) * 64, (q & 15) * 64, t, g_wave); }
      else if (j < n2) { int q = j - n1; transpose_tile(p.w_up, 1024, (u16*)(p.ws + WS_WUPT), 64, 0, q * 64, t, g_wave); }
      else if (j < n3) { int q = j - n2; transpose_tile(p.a_up, 1024, (u16*)(p.ws + WS_AUPT), 64, 0, q * 64, t, g_wave); }
      else { int q = j - n3; int bh = q >> 5, tl = q & 31; int b = bh >> 3, h = bh & 7;
        transpose_tile(p.cache_v + (size_t)b * 1024 * 1024 + h * 128, 1024, (u16*)(p.ws + WS_VTS) + (size_t)bh * 128 * 1088, 1088, (tl >> 1) * 64, (tl & 1) * 64, t, g_wave); }
    }
  }
}

#define LAS __attribute__((address_space(3)))
constexpr int BM = 256, BK = 64, HALF = 128, HTB = HALF * BK * 2;

DI int lds_byte(int r, int c) { const int st = (r >> 4) * 2 + (c >> 5), rr = r & 15, cc = c & 31, ob = rr * 64 + cc * 2; return st * 1024 + (ob ^ (((ob >> 9) & 1) << 5)); }
DI void stage_rc(int b, int& R, int& C) { const int st = b / 1024, sb = b % 1024, swz = sb ^ (((sb >> 9) & 1) << 5); R = (st >> 1) * 16 + swz / 64; C = (st & 1) * 32 + (swz % 64) / 2; }

template <int MODE> DI bool gemm_unit(int i, int& pm, int& pn) {
  if (MODE == 0) {
    const int cc = (blockIdx.x & 7) * 32 + (blockIdx.x >> 3);
    const int v = i * 256 + cc;
    if (v >= 258 * 33) return false;
    const int g = v / 264;
    if (g < 32) { const int r = v - g * 264; pm = g * 8 + (r & 7); pn = r >> 3; }
    else { const int r = v - 32 * 264; pm = 256 + (r & 1); pn = r >> 1; }
    return true;
  } else {
    const int v = i * 256 + blockIdx.x;
    if (v >= 258 * 4) return false;
    pm = v >> 2; pn = v & 3; return true;
  }
}

DI int perm32(int rho) { const int n = rho >> 4, i = rho & 15; return 8 * (i >> 2) + 4 * n + (i & 3); }
template <int MODE>
DI void gemm_epilogue(const Params& p, const f32x4 (&acc)[2][2][4][2], int pm, int pn, int wr, int wc, int fr, int fq) {
  const int brow = pm * BM, bcol = pn * BM;
  if (MODE == 1) {
    float* C = p.out + O_Y;
#pragma unroll
    for (int ai = 0; ai < 2; ++ai)
#pragma unroll
      for (int m = 0; m < 4; ++m) {
        float* rowp = C + (size_t)(brow + ai * HALF + wr * 64 + m * 16 + fr) * 1024 + bcol + wc * 32 + 8 * fq;
#pragma unroll
        for (int bj = 0; bj < 2; ++bj) { *(f32x4*)(rowp + bj * HALF) = acc[ai][bj][m][0]; *(f32x4*)(rowp + bj * HALF + 4) = acc[ai][bj][m][1]; }
      }
  } else {
    const bool prompt = brow < TP;
    const float* rope = (const float*)(p.ws + WS_ROPE);
#pragma unroll
    for (int bj = 0; bj < 2; ++bj) {
      const int cb = bcol + bj * HALF;
      if (cb >= 8320) continue;
#pragma unroll
      for (int ai = 0; ai < 2; ++ai)
#pragma unroll
        for (int m = 0; m < 4; ++m) {
          const int row = brow + ai * HALF + wr * 64 + m * 16 + fr;
          f32x4 va = acc[ai][bj][m][0], vb = acc[ai][bj][m][1];
          const int col = cb + wc * 32 + 8 * fq;
          if (cb < 2048) {
            if ((wc & 1) == 0) {
              const int pos = prompt ? (row & 8191) : 1024 + (row & 63);
              const f32x4 c0 = *(const f32x4*)(rope + pos * 16), c1 = *(const f32x4*)(rope + pos * 16 + 4);
              const f32x4 s0 = *(const f32x4*)(rope + pos * 16 + 8), s1 = *(const f32x4*)(rope + pos * 16 + 12);
              f32x4 pa, pb;
#pragma unroll
              for (int j = 0; j < 4; ++j) { pa[j] = __shfl_xor(va[j], 16); pb[j] = __shfl_xor(vb[j], 16); }
              if (fq == 0) { for (int j = 0; j < 4; ++j) { va[j] = va[j] * c0[j] - pa[j] * s0[j]; vb[j] = vb[j] * c1[j] - pb[j] * s1[j]; } }
              else if (fq == 1) { for (int j = 0; j < 4; ++j) { va[j] = va[j] * c0[j] + pa[j] * s0[j]; vb[j] = vb[j] * c1[j] + pb[j] * s1[j]; } }
            }
            u32x4 pk = {cvtpk(va[0], va[1]), cvtpk(va[2], va[3]), cvtpk(vb[0], vb[1]), cvtpk(vb[2], vb[3])};
            if (cb < 1024) {
              *(u32x4*)((u16*)(p.ws + WS_Q) + (size_t)row * 1024 + col) = pk;
            } else {
              const int c = col - 1024;
              if (prompt) {
                float* ko = p.out + O_KP + (size_t)row * 1024 + c; *(f32x4*)ko = va; *(f32x4*)(ko + 4) = vb;
                *(u32x4*)((u16*)(p.ws + WS_K) + (size_t)row * 1024 + c) = pk;
              } else {
                const int rs = row - TP, b = rs >> 6, t = rs & 63;
                float* ko = p.out + O_KS + (size_t)rs * 1024 + c; *(f32x4*)ko = va; *(f32x4*)(ko + 4) = vb;
                *(u32x4*)((u16*)(p.ws + WS_KC) + ((size_t)b * 1088 + 1024 + t) * 1024 + c) = pk;
              }
            }
          } else if (cb < 3072) {
            const int c = col - 2048, h = c >> 7, dv = c & 127;
            if (prompt) {
              float* vo = p.out + O_VP + (size_t)row * 1024 + c; *(f32x4*)vo = va; *(f32x4*)(vo + 4) = vb;
              const int b = row >> 13, t = row & 8191;
              u16* vt = (u16*)(p.ws + WS_VT) + ((size_t)(b * 8 + h) * 128 + dv) * 8192 + t;
#pragma unroll
              for (int j = 0; j < 4; ++j) { vt[(size_t)j * 8192] = f2bf(va[j]); vt[(size_t)(j + 4) * 8192] = f2bf(vb[j]); }
            } else {
              const int rs = row - TP, b = rs >> 6, t = rs & 63;
              float* vo = p.out + O_VS + (size_t)rs * 1024 + c; *(f32x4*)vo = va; *(f32x4*)(vo + 4) = vb;
              u16* vt = (u16*)(p.ws + WS_VTS) + ((size_t)(b * 8 + h) * 128 + dv) * 1088 + 1024 + t;
#pragma unroll
              for (int j = 0; j < 4; ++j) { vt[(size_t)j * 1088] = f2bf(va[j]); vt[(size_t)(j + 4) * 1088] = f2bf(vb[j]); }
            }
          } else {
            u32x4 pk = {cvtpk(va[0], va[1]), cvtpk(va[2], va[3]), cvtpk(vb[0], vb[1]), cvtpk(vb[2], vb[3])};
            if (cb < 4096) {
              *(u32x4*)((u16*)(p.out + O_Y) + (size_t)row * 1024 + (col - 3072)) = pk;
            } else if (cb < 7296) {
              const int c = col - 4096;
              *(u32x4*)((u16*)(p.ws + WS_PS) + (size_t)row * 3200 + c) = pk;
              if (prompt) { if ((row & 8191) == 8191) { float* so = p.out + O_SHP + (size_t)(row >> 13) * 3200 + c; *(f32x4*)so = va; *(f32x4*)(so + 4) = vb; } }
              else { if ((row & 63) == 63) { float* so = p.out + O_SHS + (size_t)((row - TP) >> 6) * 3200 + c; *(f32x4*)so = va; *(f32x4*)(so + 4) = vb; } }
            } else {
              *(u32x4*)((u16*)(p.out + O_Y) + (size_t)TT * 1024 + (size_t)row * 1024 + (col - 7296)) = pk;
            }
          }
        }
    }
  }
}

template <int MODE>
DI void gemm_phase(const Params& p, char* smem, const int g_wave) {
  constexpr int K = MODE == 0 ? 1024 : 2048, nt = K / BK;
  LAS unsigned char* lds = (LAS unsigned char*)smem;
  LAUNDER_TID(tid);
  const int wid = __builtin_amdgcn_readfirstlane(tid >> 6), lane = tid & 63, wr = wid >> 2, wc = wid & 3, fr = lane & 15, fq = lane >> 4;
  unsigned voffA0[2], voffA1[2], voffB[2];
#pragma unroll
  for (int i = 0; i < 2; ++i) { int R, C; stage_rc(tid * 16 + i * 8192, R, C);
    const int Rb = (R & ~31) + perm32(R & 31);
    voffA0[i] = (unsigned)(R * 1024 + C) * 2u; voffA1[i] = (unsigned)(R * 3200 + C) * 2u; voffB[i] = (unsigned)(Rb * K + C) * 2u; }
  const unsigned ldsw = (unsigned)wid * 1024u;
  const int aoff = lds_byte(wr * 64 + fr, fq * 8), boff = lds_byte(wc * 32 + fr, fq * 8);
  const char* Bbase = p.ws + (MODE == 0 ? WS_WINT : WS_WOUTT);
#define G_SA(b, h) (((b) * 2 + (h)) * HTB)
#define G_SB(b, h) ((4 + (b) * 2 + (h)) * HTB)
#define G_STAGE_B(bufoff, upn, kt_, h_) do { const char* _g = Bbase + ((size_t)((upn) * 256 + (h_) * 128) * K + (size_t)(kt_) * 64) * 2; \
    _Pragma("unroll") for (int _i = 0; _i < 2; ++_i) \
      __builtin_amdgcn_global_load_lds((const unsigned*)(_g + voffB[_i]), (LAS unsigned*)(lds + (bufoff) + ldsw + _i * 8192), 16, 0, 0); } while (0)
#define G_STAGE_A(bufoff, upm, kt_, h_) do { \
    if (MODE == 0 || (kt_) < 16) { const char* _g = p.ws + (MODE == 0 ? WS_H : WS_Q) + ((size_t)((upm) * 256 + (h_) * 128) * 1024 + (size_t)(kt_) * 64) * 2; \
      _Pragma("unroll") for (int _i = 0; _i < 2; ++_i) \
        __builtin_amdgcn_global_load_lds((const unsigned*)(_g + voffA0[_i]), (LAS unsigned*)(lds + (bufoff) + ldsw + _i * 8192), 16, 0, 0); } \
    else { const char* _g = p.ws + WS_PS + ((size_t)((upm) * 256 + (h_) * 128) * 3200 + (size_t)((kt_) - 16) * 64) * 2; \
      _Pragma("unroll") for (int _i = 0; _i < 2; ++_i) \
        __builtin_amdgcn_global_load_lds((const unsigned*)(_g + voffA1[_i]), (LAS unsigned*)(lds + (bufoff) + ldsw + _i * 8192), 16, 0, 0); } } while (0)
#define G_LDA(dst, b, h) do { _Pragma("unroll") for (int m = 0; m < 4; ++m) _Pragma("unroll") for (int k = 0; k < 2; ++k) dst[m][k] = *(const LAS bf16x8*)(lds + G_SA(b, h) + aoff + m * 2048 + k * 1024); } while (0)
#define G_LDB(dst, b, h) do { _Pragma("unroll") for (int n = 0; n < 2; ++n) _Pragma("unroll") for (int k = 0; k < 2; ++k) dst[n][k] = *(const LAS bf16x8*)(lds + G_SB(b, h) + boff + n * 2048 + k * 1024); } while (0)
#define G_MMA(ai, bj, At, Bt_) do { __builtin_amdgcn_s_setprio(1); _Pragma("unroll") for (int m = 0; m < 4; ++m) _Pragma("unroll") for (int n = 0; n < 2; ++n) _Pragma("unroll") for (int k = 0; k < 2; ++k) \
    acc[ai][bj][m][n] = __builtin_amdgcn_mfma_f32_16x16x32_bf16(Bt_[n][k], At[m][k], acc[ai][bj][m][n], 0, 0, 0); __builtin_amdgcn_s_setprio(0); } while (0)
#define G_WAIT_V(n) asm volatile("s_waitcnt vmcnt(" #n ")" ::: "memory")
#define G_WAIT_L(n) asm volatile("s_waitcnt lgkmcnt(" #n ")" ::: "memory")
#define G_BAR __builtin_amdgcn_s_barrier()
#define G_SCHED __builtin_amdgcn_sched_barrier(0)
  int cpm, cpn, npm = 0, npn = 0, ui = 0;
  if (!gemm_unit<MODE>(0, cpm, cpn)) return;
  f32x4 acc[2][2][4][2];
#pragma unroll
  for (int a = 0; a < 2; ++a)
#pragma unroll
    for (int b = 0; b < 2; ++b)
#pragma unroll
      for (int m = 0; m < 4; ++m)
#pragma unroll
        for (int n = 0; n < 2; ++n) acc[a][b][m][n] = (f32x4){0.f, 0.f, 0.f, 0.f};
  bf16x8 At[4][2], B0[2][2], B1[2][2];
  G_STAGE_B(G_SB(0, 0), cpn, 0, 0); G_STAGE_A(G_SA(0, 0), cpm, 0, 0); G_STAGE_B(G_SB(0, 1), cpn, 0, 1); G_STAGE_A(G_SA(0, 1), cpm, 0, 1);
  if (wr == 1) G_BAR;
  G_WAIT_V(4); G_BAR;
  G_STAGE_B(G_SB(1, 0), cpn, 1, 0); G_STAGE_A(G_SA(1, 0), cpm, 1, 0); G_STAGE_B(G_SB(1, 1), cpn, 1, 1);
  G_WAIT_V(6); G_BAR;
  for (;;) {
    const bool has_next = gemm_unit<MODE>(ui + 1, npm, npn);
    if (!has_next) { npm = cpm; npn = cpn; }
#pragma unroll 1
    for (int t = 0; t < nt; t += 2) {
      const bool last = (t == nt - 2);
      const int pm2 = last ? npm : cpm, pn2 = last ? npn : cpn, t2 = last ? 0 : t + 2, t3 = t2 + 1;
      G_LDB(B0, 0, 0); G_SCHED; G_LDA(At, 0, 0); G_STAGE_A(G_SA(1, 1), cpm, t + 1, 1);
      G_WAIT_L(8); G_BAR; G_WAIT_L(0); G_MMA(0, 0, At, B0); G_BAR; G_SCHED;
      G_LDB(B1, 0, 1); G_STAGE_B(G_SB(0, 0), pn2, t2, 0);
      G_BAR; G_WAIT_L(0); G_MMA(0, 1, At, B1); G_BAR;
      G_LDA(At, 0, 1); G_STAGE_A(G_SA(0, 0), pm2, t2, 0);
      G_BAR; G_WAIT_L(0); G_MMA(1, 0, At, B0); G_BAR; G_SCHED;
      G_STAGE_B(G_SB(0, 1), pn2, t2, 1);
      G_WAIT_V(6); G_BAR; G_MMA(1, 1, At, B1); G_BAR;
      G_LDB(B0, 1, 0); G_SCHED; G_LDA(At, 1, 0); G_STAGE_A(G_SA(0, 1), pm2, t2, 1);
      G_WAIT_L(8); G_BAR; G_WAIT_L(0); G_MMA(0, 0, At, B0); G_BAR; G_SCHED;
      G_LDB(B1, 1, 1); G_STAGE_B(G_SB(1, 0), pn2, t3, 0);
      G_BAR; G_WAIT_L(0); G_MMA(0, 1, At, B1); G_BAR;
      G_LDA(At, 1, 1); G_STAGE_A(G_SA(1, 0), pm2, t3, 0);
      G_BAR; G_WAIT_L(0); G_MMA(1, 0, At, B0); G_BAR; G_SCHED;
      G_STAGE_B(G_SB(1, 1), pn2, t3, 1);
      G_WAIT_V(6); G_BAR; G_MMA(1, 1, At, B1); G_BAR;
    }
    gemm_epilogue<MODE>(p, acc, cpm, cpn, wr, wc, fr, fq);
    if (!has_next) break;
#pragma unroll
    for (int a = 0; a < 2; ++a)
#pragma unroll
      for (int b = 0; b < 2; ++b)
#pragma unroll
        for (int m = 0; m < 4; ++m)
#pragma unroll
          for (int n = 0; n < 2; ++n) acc[a][b][m][n] = (f32x4){0.f, 0.f, 0.f, 0.f};
    cpm = npm; cpn = npn; ++ui;
  }
  G_WAIT_V(0);
  if (wr == 0) G_BAR;
  G_BAR;
#undef G_SA
#undef G_SB
#undef G_STAGE_A
#undef G_STAGE_B
#undef G_LDA
#undef G_LDB
#undef G_MMA
}

DI void phase1(const Params& p, char* smem, const int g_wave) { gemm_phase<0>(p, smem, g_wave); }
DI void phase3(const Params& p, char* smem, const int g_wave) { gemm_phase<1>(p, smem, g_wave); }

constexpr int KBUF = 64 * 256, VBUF = 128 * 128, QWAVE = 32 * 272;

DI void attn_item(const Params& p, char* smem, u16* qbase, const u16* gabase, const u16* kbase, const u16* vtbase,
                  int tkv, int nkt, int mylimit, const float* lam_p, const int g_wave) {
  LAUNDER_TID(tid);
  const int lane = tid & 63, wid = __builtin_amdgcn_readfirstlane(tid >> 6), r = lane & 31, hh = lane >> 5;
  constexpr float C = 0.125f * 1.4426950408889634f;
  LAS unsigned char* lds = (LAS unsigned char*)smem;
  char* Kb = smem; char* Vb = smem + 2 * KBUF; char* Qs = smem + 2 * KBUF + 2 * VBUF + wid * QWAVE;
  if (mylimit > 0) {
#pragma unroll
    for (int i = 0; i < 8; ++i) { const int id = i * 64 + lane, row = id >> 4, cc = id & 15;
      *(uint4*)(Qs + row * 272 + cc * 16) = *(const uint4*)(qbase + (size_t)(wid * 32 + row) * 1024 + cc * 8); }
  }
  unsigned kso[2], vso[2];
#pragma unroll
  for (int i = 0; i < 2; ++i) {
    const int krow = 4 * (2 * wid + i) + (lane >> 4), kpos = lane & 15;
    kso[i] = (unsigned)(krow * 1024 + ((kpos ^ (krow & 15)) * 8)) * 2u;
    const int vrow = 8 * (2 * wid + i) + (lane >> 3), vpos = lane & 7;
    vso[i] = (unsigned)(vrow * tkv + ((vpos ^ ((vrow >> 1) & 7)) * 8)) * 2u;
  }
#define STAGE_KV(buf, kt) do { const char* kb_ = (const char*)kbase + (size_t)(kt) * 131072; const char* vb_ = (const char*)vtbase + (size_t)(kt) * 128; \
    _Pragma("unroll") for (int i = 0; i < 2; ++i) { \
      __builtin_amdgcn_global_load_lds((const unsigned*)(kb_ + kso[i]), (LAS unsigned*)(lds + (buf) * KBUF + (2 * wid + i) * 1024), 16, 0, 0); \
      __builtin_amdgcn_global_load_lds((const unsigned*)(vb_ + vso[i]), (LAS unsigned*)(lds + 2 * KBUF + (buf) * VBUF + (2 * wid + i) * 1024), 16, 0, 0); } } while (0)
  f32x16 O0[4], O1[4];
#pragma unroll
  for (int d = 0; d < 4; ++d) { O0[d] = f32x16{}; O1[d] = f32x16{}; }
  float l0 = 0.f, l1 = 0.f, m0 = -1e30f, m1 = -1e30f;
#define SOFTMAX_COMP(cidx, LREG, MREG, OARR, PF) do { \
      f32x16 s0 = f32x16{}, s1 = f32x16{}; \
      _Pragma("unroll") for (int s = 0; s < 4; ++s) { \
        const int ch = (cidx) * 8 + s * 2 + hh; \
        const bf16x8 qf = *(const bf16x8*)(Qk + r * 272 + ((cidx) * 64 + s * 16 + hh * 8) * 2); \
        const bf16x8 ka = *(const bf16x8*)(Kt + r * 256 + ((ch * 16) ^ kz)); \
        const bf16x8 kb = *(const bf16x8*)(Kt + (32 + r) * 256 + ((ch * 16) ^ kz)); \
        s0 = __builtin_amdgcn_mfma_f32_32x32x16_bf16(ka, qf, s0, 0, 0, 0); \
        s1 = __builtin_amdgcn_mfma_f32_32x32x16_bf16(kb, qf, s1, 0, 0, 0); } \
      float tm = s0[0]; \
      _Pragma("unroll") for (int i = 1; i < 16; ++i) tm = fmaxf(tm, s0[i]); \
      _Pragma("unroll") for (int i = 0; i < 16; ++i) tm = fmaxf(tm, s1[i]); \
      { auto rr = __builtin_amdgcn_permlane32_swap(__float_as_uint(tm), __float_as_uint(tm), false, false); \
        tm = fmaxf(__uint_as_float(rr[0]), __uint_as_float(rr[1])); } \
      tm *= C; \
      if (!__all(tm <= MREG + 8.f)) { \
        const float mn = fmaxf(MREG, tm); const float sc = __builtin_amdgcn_exp2f(MREG - mn); \
        MREG = mn; LREG *= sc; \
        _Pragma("unroll") for (int d = 0; d < 4; ++d) _Pragma("unroll") for (int i = 0; i < 16; ++i) OARR[d][i] *= sc; } \
      const float mneg = -MREG; float ps = 0.f; \
      _Pragma("unroll") for (int i = 0; i < 16; ++i) { s0[i] = __builtin_amdgcn_exp2f(fmaf(s0[i], C, mneg)); ps += s0[i]; } \
      _Pragma("unroll") for (int i = 0; i < 16; ++i) { s1[i] = __builtin_amdgcn_exp2f(fmaf(s1[i], C, mneg)); ps += s1[i]; } \
      LREG += ps; \
      _Pragma("unroll") for (int s = 0; s < 2; ++s) { \
        u32x4 w0 = {cvtpk(s0[8 * s + 0], s0[8 * s + 1]), cvtpk(s0[8 * s + 2], s0[8 * s + 3]), cvtpk(s0[8 * s + 4], s0[8 * s + 5]), cvtpk(s0[8 * s + 6], s0[8 * s + 7])}; \
        u32x4 w1 = {cvtpk(s1[8 * s + 0], s1[8 * s + 1]), cvtpk(s1[8 * s + 2], s1[8 * s + 3]), cvtpk(s1[8 * s + 4], s1[8 * s + 5]), cvtpk(s1[8 * s + 6], s1[8 * s + 7])}; \
        PF[s] = *reinterpret_cast<bf16x8*>(&w0); PF[2 + s] = *reinterpret_cast<bf16x8*>(&w1); } } while (0)

  STAGE_KV(0, 0);
  asm volatile("s_waitcnt vmcnt(0)" ::: "memory");
  __syncthreads();
#pragma unroll 1
  for (int kt = 0; kt < nkt; ++kt) {
    if (kt + 1 < nkt) STAGE_KV((kt + 1) & 1, kt + 1);
    if (kt < mylimit) {
      const char* Kt = Kb + (kt & 1) * KBUF;
      const char* Vt = Vb + (kt & 1) * VBUF;
      int zq = 0, kz = (r & 15) * 16, vz = ((r >> 1) & 7) * 16;
      asm volatile("" : "+v"(zq), "+v"(kz), "+v"(vz));
      const char* Qk = Qs + zq;
      bf16x8 pf0[4], pf1[4];
      SOFTMAX_COMP(0, l0, m0, O0, pf0);
      __builtin_amdgcn_sched_barrier(0);
      SOFTMAX_COMP(1, l1, m1, O1, pf1);
      __builtin_amdgcn_sched_barrier(0);
#pragma unroll
      for (int d = 0; d < 4; ++d) {
        const int vrow = 32 * d + r;
#pragma unroll
        for (int sp = 0; sp < 4; ++sp) {
          const u32x2 lo = *(const u32x2*)(Vt + vrow * 128 + ((32 * sp) ^ vz) + 8 * hh);
          const u32x2 hi = *(const u32x2*)(Vt + vrow * 128 + ((32 * sp + 16) ^ vz) + 8 * hh);
          u32x4 w = {lo[0], lo[1], hi[0], hi[1]};
          const bf16x8 vf = *reinterpret_cast<bf16x8*>(&w);
          O0[d] = __builtin_amdgcn_mfma_f32_32x32x16_bf16(vf, pf0[sp], O0[d], 0, 0, 0);
          O1[d] = __builtin_amdgcn_mfma_f32_32x32x16_bf16(vf, pf1[sp], O1[d], 0, 0, 0);
        }
        __builtin_amdgcn_sched_barrier(0);
      }
    }
    asm volatile("s_waitcnt vmcnt(0)" ::: "memory");
    __syncthreads();
  }
#undef STAGE_KV
#undef SOFTMAX_COMP
  if (mylimit > 0) {
    LAUNDER_TID(tid2);
    const int lane = tid2 & 63, wid = tid2 >> 6, r = lane & 31, hh = lane >> 5;
    u16* qrow = qbase + (size_t)(wid * 32 + r) * 1024;
    { auto rr = __builtin_amdgcn_permlane32_swap(__float_as_uint(l0), __float_as_uint(l0), false, false);
      l0 = __uint_as_float(rr[0]) + __uint_as_float(rr[1]); }
    { auto rr = __builtin_amdgcn_permlane32_swap(__float_as_uint(l1), __float_as_uint(l1), false, false);
      l1 = __uint_as_float(rr[0]) + __uint_as_float(rr[1]); }
    const float i0 = 1.f / l0, i1 = *lam_p / l1;
    float ss = 0.f;
#pragma unroll
    for (int d = 0; d < 4; ++d)
#pragma unroll
      for (int i = 0; i < 16; ++i) { float v = O0[d][i] * i0 - O1[d][i] * i1; O0[d][i] = v; ss += v * v; }
    { auto rr = __builtin_amdgcn_permlane32_swap(__float_as_uint(ss), __float_as_uint(ss), false, false);
      ss = __uint_as_float(rr[0]) + __uint_as_float(rr[1]); }
    const float rs = rsqrtf(ss * (1.f / 128.f) + 1e-5f) * 0.8f;
    const u16* garow = gabase + (size_t)(wid * 32 + r) * 1024;
#pragma unroll
    for (int d = 0; d < 4; ++d)
#pragma unroll
      for (int g = 0; g < 4; ++g) {
        int dv = 32 * d + 8 * g + 4 * hh;
        u32x2 gg = *(const u32x2*)(garow + dv);
        float4 sl = *(const float4*)(p.subln + dv);
        float g0 = __uint_as_float(gg[0] << 16), g1 = __uint_as_float(gg[0] & 0xffff0000u), g2 = __uint_as_float(gg[1] << 16), g3 = __uint_as_float(gg[1] & 0xffff0000u);
        float o0 = O0[d][4 * g + 0] * rs * sl.x * silu(g0);
        float o1 = O0[d][4 * g + 1] * rs * sl.y * silu(g1);
        float o2 = O0[d][4 * g + 2] * rs * sl.z * silu(g2);
        float o3 = O0[d][4 * g + 3] * rs * sl.w * silu(g3);
        u32x2 o; o[0] = cvtpk(o0, o1); o[1] = cvtpk(o2, o3);
        *(u32x2*)(qrow + dv) = o;
      }
  }
}

DI void Yreg_store(float* Y, int idx, float y) { Y[idx] = y; }
DI void scan_item(const Params& p, char* smem, int b, int h, bool prompt, const int g_wave) {
  LAUNDER_TID(tid);
  const int lane = tid & 63, wid = g_wave;
  constexpr int SETB = 57728;
  constexpr int O_AWD = 2 * SETB, O_AAD = O_AWD + 4608, O_CARRY = O_AAD + 4608, O_CST = O_CARRY + 1280, O_WL = O_CST + 3072;
  float* carry = (float*)(smem + O_CARRY);
  float* cst = (float*)(smem + O_CST);
  char* WL = smem + O_WL;
  u16* PS = (u16*)(p.ws + WS_PS);
  const u16* GB = (const u16*)(p.out + O_Y) + (size_t)TT * 1024;
  const size_t row0 = prompt ? (size_t)b * 8192 : (size_t)TP + b * 64;
  const int nch = prompt ? 256 : 2;
  for (int i = tid; i < 768; i += 512) {
    float cv;
    if (i < 320) { int seg = i >> 6, cc = i & 63; int col = seg < 3 ? seg * 1024 + h * 64 + cc : 3072 + (seg - 3) * 64 + cc; cv = p.mu[col];
      carry[i] = prompt ? 0.f : p.state_shift[(size_t)b * 3200 + col]; }
    else { int idx = i - 320, which = idx >> 6, cc = h * 64 + (idx & 63);
      const float* src = which == 0 ? p.w0 : which == 1 ? p.a0 : which == 2 ? p.k_k : which == 3 ? p.k_a : which == 4 ? p.r_k : which == 5 ? p.ln_w : p.ln_b;
      cv = src[cc]; }
    cst[i] = cv;
  }
  for (int id = tid; id < 1024; id += 512) {
    const int mt = id >> 9, row = (id >> 3) & 63, cc = id & 7;
    *(uint4*)(WL + mt * 9216 + row * 144 + cc * 16) = *(const uint4*)((const u16*)(p.ws + (mt == 0 ? WS_WUPT : WS_AUPT)) + (size_t)(h * 64 + row) * 64 + cc * 8);
  }
  __syncthreads();

  if (wid < 4) {
    typedef float f32x2 __attribute__((ext_vector_type(2)));
    typedef float f32x4v __attribute__((ext_vector_type(4)));
    const int li = lane & 15, g = lane >> 4, irow = wid * 16 + li;
    f32x2 S0[4], S1[4];
    if (prompt) { for (int e = 0; e < 4; ++e) { S0[e] = (f32x2){0.f, 0.f}; S1[e] = (f32x2){0.f, 0.f}; } }
    else {
      const float* s0 = p.state_wkv + ((size_t)(b * 16 + h) * 64 + irow) * 64 + 8 * g;
      for (int e = 0; e < 4; ++e) { S0[e] = (f32x2){s0[2 * e], s0[2 * e + 1]}; S1[e] = (f32x2){s0[32 + 2 * e], s0[32 + 2 * e + 1]}; }
    }
    const int abf_off = ((lane & 3) == 1 ? 12288 : 8192) + 16 * g;
    __syncthreads();
#pragma unroll 1
    for (int k = 0; k < nch; ++k) {
      const char* set = smem + (k & 1) * SETB;
      const float* bW = (const float*)set + 8 * g;
      const char* bA = set + abf_off;
      const float* bV = (const float*)(set + 40960) + irow;
      float* Yp = (float*)(set + 49152) + irow;
      const float2* BK = (const float2*)(set + 57472);
#define LOADV(X, t) do { \
        X##w0 = *(const f32x4v*)(bW + (t) * 64); X##w1 = *(const f32x4v*)(bW + (t) * 64 + 4); X##w2 = *(const f32x4v*)(bW + (t) * 64 + 32); X##w3 = *(const f32x4v*)(bW + (t) * 64 + 36); \
        X##b0 = *(const f32x4v*)(bW + 4096 + (t) * 64); X##b1 = *(const f32x4v*)(bW + 4096 + (t) * 64 + 4); X##b2 = *(const f32x4v*)(bW + 4096 + (t) * 64 + 32); X##b3 = *(const f32x4v*)(bW + 4096 + (t) * 64 + 36); \
        X##k0 = *(const f32x4v*)(bW + 6144 + (t) * 64); X##k1 = *(const f32x4v*)(bW + 6144 + (t) * 64 + 4); X##k2 = *(const f32x4v*)(bW + 6144 + (t) * 64 + 32); X##k3 = *(const f32x4v*)(bW + 6144 + (t) * 64 + 36); \
        X##a0 = *(const bf16x8*)(bA + (t) * 128); X##a1 = *(const bf16x8*)(bA + (t) * 128 + 64); \
        X##v = bV[(t) * 64]; X##s = BK[t]; } while (0)
#define LO2(x) __builtin_shufflevector(x, x, 0, 1)
#define HI2(x) __builtin_shufflevector(x, x, 2, 3)
#define FMA2 __builtin_elementwise_fma
#define STEP(X, t) do { \
        u32x4 c0 = {cvtpk(S0[0].x, S0[0].y), cvtpk(S0[1].x, S0[1].y), cvtpk(S0[2].x, S0[2].y), cvtpk(S0[3].x, S0[3].y)}; \
        u32x4 c1 = {cvtpk(S1[0].x, S1[0].y), cvtpk(S1[1].x, S1[1].y), cvtpk(S1[2].x, S1[2].y), cvtpk(S1[3].x, S1[3].y)}; \
        f32x4 acc = {0.f, 0.f, 0.f, 0.f}; \
        acc = __builtin_amdgcn_mfma_f32_16x16x32_bf16(X##a0, *reinterpret_cast<bf16x8*>(&c0), acc, 0, 0, 0); \
        acc = __builtin_amdgcn_mfma_f32_16x16x32_bf16(X##a1, *reinterpret_cast<bf16x8*>(&c1), acc, 0, 0, 0); \
        const float sa = acc[0]; \
        const f32x2 sav = {sa, sa}, vv = {X##v, X##v}; \
        S0[0] = FMA2(S0[0], LO2(X##w0), FMA2(sav, LO2(X##b0), vv * LO2(X##k0))); S0[1] = FMA2(S0[1], HI2(X##w0), FMA2(sav, HI2(X##b0), vv * HI2(X##k0))); \
        S0[2] = FMA2(S0[2], LO2(X##w1), FMA2(sav, LO2(X##b1), vv * LO2(X##k1))); S0[3] = FMA2(S0[3], HI2(X##w1), FMA2(sav, HI2(X##b1), vv * HI2(X##k1))); \
        S1[0] = FMA2(S1[0], LO2(X##w2), FMA2(sav, LO2(X##b2), vv * LO2(X##k2))); S1[1] = FMA2(S1[1], HI2(X##w2), FMA2(sav, HI2(X##b2), vv * HI2(X##k2))); \
        S1[2] = FMA2(S1[2], LO2(X##w3), FMA2(sav, LO2(X##b3), vv * LO2(X##k3))); S1[3] = FMA2(S1[3], HI2(X##w3), FMA2(sav, HI2(X##b3), vv * HI2(X##k3))); \
        const float y = fmaf(sa, X##s.x, fmaf(X##v, X##s.y, acc[1])); \
        Yp[(t) * 64] = y; } while (0)
      f32x4v Pw0, Pw1, Pw2, Pw3, Pb0, Pb1, Pb2, Pb3, Pk0, Pk1, Pk2, Pk3; bf16x8 Pa0, Pa1; float Pv; float2 Ps;
      f32x4v Qw0, Qw1, Qw2, Qw3, Qb0, Qb1, Qb2, Qb3, Qk0, Qk1, Qk2, Qk3; bf16x8 Qa0, Qa1; float Qv; float2 Qs;
      LOADV(P, 0);
#pragma unroll 1
      for (int t = 0; t < 32; t += 4) {
        LOADV(Q, t + 1);
        STEP(P, t);
        LOADV(P, t + 2);
        STEP(Q, t + 1);
        LOADV(Q, t + 3);
        STEP(P, t + 2);
        LOADV(P, t + 4);
        STEP(Q, t + 3);
      }
#undef LOADV
#undef STEP
      asm volatile("s_waitcnt lgkmcnt(0)" ::: "memory");
      __builtin_amdgcn_s_barrier();
      asm volatile("" ::: "memory");
    }
    float* so = p.out + (prompt ? O_WKVP : O_WKVS) + ((size_t)(b * 16 + h) * 64 + irow) * 64 + 8 * g;
    *(float4*)so = make_float4(S0[0].x, S0[0].y, S0[1].x, S0[1].y); *(float4*)(so + 4) = make_float4(S0[2].x, S0[2].y, S0[3].x, S0[3].y);
    *(float4*)(so + 32) = make_float4(S1[0].x, S1[0].y, S1[1].x, S1[1].y); *(float4*)(so + 36) = make_float4(S1[2].x, S1[2].y, S1[3].x, S1[3].y);
#undef LO2
#undef HI2
#undef FMA2
  } else {
    const int pw = wid - 4, tl = lane >> 3, sub = lane & 7, tA = pw * 8 + tl;
    u16* Awd = (u16*)(smem + O_AWD); u16* Aad = (u16*)(smem + O_AAD);
    u32x4 cur[5], prv[5], gg;
    float c_mu[5][8], c_kk[8], c_ka[8], c_rk[8], c_w0[4], c_a0[4];
#pragma unroll
    for (int e = 0; e < 8; ++e) {
#pragma unroll
      for (int seg = 0; seg < 5; ++seg) c_mu[seg][e] = cst[seg * 64 + sub * 8 + e];
      c_kk[e] = cst[448 + sub * 8 + e]; c_ka[e] = cst[512 + sub * 8 + e]; c_rk[e] = cst[576 + sub * 8 + e];
    }
#pragma unroll
    for (int nt = 0; nt < 4; ++nt) { c_w0[nt] = cst[320 + 16 * nt + (lane & 15)]; c_a0[nt] = cst[384 + 16 * nt + (lane & 15)]; }
#define PS_COL(seg) ((seg) < 3 ? (seg) * 1024 + h * 64 + sub * 8 : 3072 + ((seg) - 3) * 64 + sub * 8)
#define PREFETCH(ch_) do { const size_t rb_ = row0 + (size_t)(ch_) * 32 + tA; \
      _Pragma("unroll") for (int seg = 0; seg < 5; ++seg) { \
        cur[seg] = *(const u32x4*)(PS + rb_ * 3200 + PS_COL(seg)); \
        if ((ch_) > 0 || tA > 0) prv[seg] = *(const u32x4*)(PS + (rb_ - 1) * 3200 + PS_COL(seg)); } } while (0)
#define PREP_ABC(ch_) do { \
      char* set = smem + ((ch_) & 1) * SETB; \
      float* W = (float*)set; float* A = W + 2048; float* B = W + 4096; float* Kp = W + 6144; float* R = W + 8192; float* V = W + 10240; \
      float* bonus = (float*)(set + 57344); float2* BRKR = (float2*)(set + 57472); \
      _Pragma("unroll") for (int seg = 0; seg < 5; ++seg) { \
        float cf[8], pf_[8]; \
        _Pragma("unroll") for (int e = 0; e < 4; ++e) { cf[2 * e] = __uint_as_float(cur[seg][e] << 16); cf[2 * e + 1] = __uint_as_float(cur[seg][e] & 0xffff0000u); } \
        if ((ch_) > 0 || tA > 0) { \
          _Pragma("unroll") for (int e = 0; e < 4; ++e) { pf_[2 * e] = __uint_as_float(prv[seg][e] << 16); pf_[2 * e + 1] = __uint_as_float(prv[seg][e] & 0xffff0000u); } \
        } else { \
          _Pragma("unroll") for (int e = 0; e < 8; ++e) pf_[e] = carry[seg * 64 + sub * 8 + e]; } \
        float mv[8]; \
        _Pragma("unroll") for (int e = 0; e < 8; ++e) mv[e] = cf[e] + (pf_[e] - cf[e]) * c_mu[seg][e]; \
        if (seg == 0) { for (int e = 0; e < 8; ++e) R[tA * 64 + sub * 8 + e] = mv[e]; } \
        else if (seg == 1) { for (int e = 0; e < 8; ++e) Kp[tA * 64 + sub * 8 + e] = mv[e]; } \
        else if (seg == 2) { for (int e = 0; e < 8; ++e) V[tA * 64 + sub * 8 + e] = mv[e]; } \
        else if (seg == 3) { for (int e = 0; e < 8; ++e) { float ex = __expf(2.f * mv[e]); Awd[tA * 72 + sub * 8 + e] = f2bf(1.f - 2.f * __builtin_amdgcn_rcpf(ex + 1.f)); } } \
        else { for (int e = 0; e < 8; ++e) Aad[tA * 72 + sub * 8 + e] = f2bf(mv[e]); } } \
      asm volatile("s_waitcnt lgkmcnt(0)" ::: "memory"); \
      {   \
        const int l15 = lane & 15, lg = lane >> 4; \
        f32x4 accB[2][4]; \
        _Pragma("unroll") for (int mt = 0; mt < 2; ++mt) { \
          const u16* As = mt == 0 ? Awd : Aad; \
          const bf16x8 af0 = *(const bf16x8*)(As + (pw * 8 + (l15 & 7)) * 72 + 8 * lg); \
          const bf16x8 af1 = *(const bf16x8*)(As + (pw * 8 + (l15 & 7)) * 72 + 8 * lg + 32); \
          _Pragma("unroll") for (int nt = 0; nt < 4; ++nt) { \
            const char* wp = WL + mt * 9216 + (16 * nt + l15) * 144 + 16 * lg; \
            f32x4 acc = {0.f, 0.f, 0.f, 0.f}; \
            acc = __builtin_amdgcn_mfma_f32_16x16x32_bf16(af0, *(const bf16x8*)wp, acc, 0, 0, 0); \
            accB[mt][nt] = __builtin_amdgcn_mfma_f32_16x16x32_bf16(af1, *(const bf16x8*)(wp + 64), acc, 0, 0, 0); } } \
        if (lg < 2) { \
          _Pragma("unroll") for (int nt = 0; nt < 4; ++nt) { \
            const int n = 16 * nt + l15; \
            _Pragma("unroll") for (int j = 0; j < 4; ++j) { \
              const int t = pw * 8 + 4 * lg + j; \
                \
              const float sg = __builtin_amdgcn_rcpf(1.f + __expf(-(c_w0[nt] + accB[0][nt][j]))); \
              W[t * 64 + n] = __expf(-0.60653066f * sg); \
              B[t * 64 + n] = __builtin_amdgcn_rcpf(1.f + __expf(-(c_a0[nt] + accB[1][nt][j]))); } } } } \
      asm volatile("s_waitcnt lgkmcnt(0)" ::: "memory"); \
      {   \
        float kkv[8], lr[8], kr[8]; float ssq = 0.f; \
        _Pragma("unroll") for (int e = 0; e < 8; ++e) { int j = sub * 8 + e; kr[e] = Kp[tA * 64 + j]; lr[e] = B[tA * 64 + j]; kkv[e] = kr[e] * c_kk[e]; ssq += kkv[e] * kkv[e]; } \
        ssq = DPP_ADD(ssq, 0xB1); ssq = DPP_ADD(ssq, 0x4E); ssq = DPP_ADD(ssq, 0x141); \
        float inv = __builtin_amdgcn_rsqf(fmaxf(ssq, 1e-24f)); \
        float bs = 0.f, s_br = 0.f, s_kr = 0.f; float an[8], wrn[8]; \
        _Pragma("unroll") for (int e = 0; e < 8; ++e) { int j = sub * 8 + e; \
          float kn = kkv[e] * inv; float bb = kn * lr[e]; float k2 = kr[e] * (1.f + (lr[e] - 1.f) * c_ka[e]); float rr = R[tA * 64 + j]; \
          an[e] = -kn; B[tA * 64 + j] = bb; Kp[tA * 64 + j] = k2; wrn[e] = rr * W[tA * 64 + j]; \
          bs += rr * k2 * c_rk[e]; s_br += bb * rr; s_kr += k2 * rr; } \
        { u32x4 pa = {cvtpk(an[0], an[1]), cvtpk(an[2], an[3]), cvtpk(an[4], an[5]), cvtpk(an[6], an[7])}; \
          u32x4 pw_ = {cvtpk(wrn[0], wrn[1]), cvtpk(wrn[2], wrn[3]), cvtpk(wrn[4], wrn[5]), cvtpk(wrn[6], wrn[7])}; \
          *(u32x4*)(set + 8192 + tA * 128 + sub * 16) = pa; *(u32x4*)(set + 12288 + tA * 128 + sub * 16) = pw_; } \
        bs = DPP_ADD(bs, 0xB1); bs = DPP_ADD(bs, 0x4E); bs = DPP_ADD(bs, 0x141); \
        s_br = DPP_ADD(s_br, 0xB1); s_br = DPP_ADD(s_br, 0x4E); s_br = DPP_ADD(s_br, 0x141); \
        s_kr = DPP_ADD(s_kr, 0xB1); s_kr = DPP_ADD(s_kr, 0x4E); s_kr = DPP_ADD(s_kr, 0x141); \
        if (sub == 0) { bonus[tA] = bs; BRKR[tA] = make_float2(s_br, s_kr); } } } while (0)
#define PREP_E(ch_) do { \
      const char* set = smem + ((ch_) & 1) * SETB; \
      const float* V = (const float*)(set + 40960); const float* Y = (const float*)(set + 49152); const float* bonus = (const float*)(set + 57344); \
      float yv[8]; float s1 = 0.f; \
      _Pragma("unroll") for (int e = 0; e < 8; ++e) { yv[e] = Y[tA * 64 + sub * 8 + e]; s1 += yv[e]; } \
      s1 = DPP_ADD(s1, 0xB1); s1 = DPP_ADD(s1, 0x4E); s1 = DPP_ADD(s1, 0x141); \
      float mean = s1 * (1.f / 64.f); float s2 = 0.f; \
      _Pragma("unroll") for (int e = 0; e < 8; ++e) { float d = yv[e] - mean; s2 += d * d; } \
      s2 = DPP_ADD(s2, 0xB1); s2 = DPP_ADD(s2, 0x4E); s2 = DPP_ADD(s2, 0x141); \
      float rstd = rsqrtf(s2 * (1.f / 64.f) + 64e-5f); \
      float bn = bonus[tA]; float gv[8], ov[8]; \
      _Pragma("unroll") for (int e = 0; e < 4; ++e) { gv[2 * e] = __uint_as_float(gg[e] << 16); gv[2 * e + 1] = __uint_as_float(gg[e] & 0xffff0000u); } \
      _Pragma("unroll") for (int e = 0; e < 8; ++e) { int i = sub * 8 + e; \
        float yy = (yv[e] - mean) * rstd * cst[640 + i] + cst[704 + i] + bn * V[tA * 64 + i]; ov[e] = yy * silu(gv[e]); } \
      u32x4 ow = {cvtpk(ov[0], ov[1]), cvtpk(ov[2], ov[3]), cvtpk(ov[4], ov[5]), cvtpk(ov[6], ov[7])}; \
      *(u32x4*)(PS + (row0 + (size_t)(ch_) * 32 + tA) * 3200 + h * 64 + sub * 8) = ow; } while (0)
#define LOAD_GG(ch_) gg = *(const u32x4*)(GB + (row0 + (size_t)(ch_) * 32 + tA) * 1024 + h * 64 + sub * 8)

    PREFETCH(0);
    PREP_ABC(0);
    if (nch > 1) PREFETCH(1);
    __syncthreads();
#pragma unroll 1
    for (int k = 0; k < nch; ++k) {
      if (k >= 1) PREP_E(k - 1);
      LOAD_GG(k);
      if (k + 1 < nch) {
        PREP_ABC(k + 1);
        if (k + 2 < nch) PREFETCH(k + 2);
      }
      asm volatile("s_waitcnt lgkmcnt(0)" ::: "memory");
      __builtin_amdgcn_s_barrier();
      asm volatile("" ::: "memory");
    }
    PREP_E(nch - 1);
#undef PREFETCH
#undef PS_COL
#undef PREP_ABC
#undef PREP_E
#undef LOAD_GG
  }
  __syncthreads();
}

DI void phase2(const Params& p, char* smem, const int g_wave) {
  __shared__ int s_item;
  __shared__ float s_lam;
  const int wid = g_wave;
  float lam;
  {
    const int lane = (int)__builtin_amdgcn_mbcnt_hi(~0u, __builtin_amdgcn_mbcnt_lo(~0u, 0u));
    float a = p.lq1[lane] * p.lk1[lane], b = p.lq2[lane] * p.lk2[lane];
    a = wave_sum(a); b = wave_sum(b);
    lam = __expf(a) - __expf(b) + 0.2f;
    if (lane == 0 && g_wave == 0) s_lam = lam;
  }
  int* ctr = (int*)(p.ws + WS_CTR);
  constexpr int N0 = 128, N1 = N0 + 2048, N2 = N1 + 128, N3 = N2 + 64;
  for (;;) {
    { LAUNDER_TID(tq); if (tq == 0) s_item = atomicAdd(ctr, 1); }
    __syncthreads();
    const int it = __builtin_amdgcn_readfirstlane(s_item);
    __syncthreads();
    if (it >= N3) break;
    const bool is_scan = it < N0 || (it >= N1 && it < N2);
    if (is_scan) {
#ifndef NOSCAN
      const bool prm = it < N0; const int c = prm ? it : it - N1;
      scan_item(p, smem, c >> 4, c & 15, prm, g_wave);
#endif
    } else {
#ifndef NOATT
      const bool prm = it < N1;
      int qb, bh;
      if (prm) { int a = it - N0; qb = 31 - (a >> 6); bh = a & 63; } else { qb = 0; bh = it - N2; }
      const int b = bh >> 3, h = bh & 7;
      const size_t rowq = prm ? (size_t)b * 8192 + qb * 256 : (size_t)TP + b * 64;
      u16* qbase = (u16*)(p.ws + WS_Q) + rowq * 1024 + h * 128;
      const u16* gabase = (const u16*)(p.out + O_Y) + rowq * 1024 + h * 128;
      const u16* kbase = prm ? (const u16*)(p.ws + WS_K) + (size_t)b * 8192 * 1024 + h * 128 : (const u16*)(p.ws + WS_KC) + (size_t)b * 1088 * 1024 + h * 128;
      const u16* vtbase = prm ? (const u16*)(p.ws + WS_VT) + (size_t)bh * 128 * 8192 : (const u16*)(p.ws + WS_VTS) + (size_t)bh * 128 * 1088;
      const int tkv = prm ? 8192 : 1088, nkt = prm ? 4 * (qb + 1) : 17;
      const int mylimit = prm ? 4 * qb + (wid >> 1) + 1 : (wid < 2 ? 17 : 0);
      attn_item(p, smem, qbase, gabase, kbase, vtbase, tkv, nkt, mylimit, &s_lam, g_wave);
#endif
    }
  }
}

DI void phase4(const Params& p, const int g_wave) {
  LAUNDER_TID(tid);
  const int lane = tid & 63, wid = tid >> 6;
  const int gw = blockIdx.x * 8 + wid, nw = gridDim.x * 8;
  float* Y = p.out + O_Y;
  for (int row = gw; row < TT; row += nw) {
    const float* x = row < TP ? p.x_prompt + (size_t)row * 1024 : p.x_sample + (size_t)(row - TP) * 1024;
    float4* yr = (float4*)(Y + (size_t)row * 1024);
    float4 v[4]; float ss = 0.f;
    for (int i = 0; i < 4; ++i) { v[i] = yr[lane + 64 * i]; ss += v[i].x * v[i].x + v[i].y * v[i].y + v[i].z * v[i].z + v[i].w * v[i].w; }
    ss = wave_sum(ss);
    float sc = rsqrtf(ss * (1.f / 1024.f) + 1e-6f);
    for (int i = 0; i < 4; ++i) {
      float4 g = ((const float4*)p.norm_post)[lane + 64 * i];
      float4 xv = ((const float4*)x)[lane + 64 * i];
      float4 o = make_float4(xv.x + v[i].x * sc * g.x, xv.y + v[i].y * sc * g.y, xv.z + v[i].z * sc * g.z, xv.w + v[i].w * sc * g.w);
      yr[lane + 64 * i] = o;
    }
  }
}

__global__ void __launch_bounds__(512) mega(Params p) {
  extern __shared__ __attribute__((aligned(16))) char smem[];
  cg::grid_group grid = cg::this_grid();
  const int lo = (int)p.ph_lo, hi = (int)p.ph_hi;
  const int g_wave = __builtin_amdgcn_readfirstlane(threadIdx.x >> 6);
  if (lo <= 0 && hi > 0) { phase0(p, smem, g_wave); if (hi > 1) grid.sync(); }
  if (lo <= 1 && hi > 1) { phase1(p, smem, g_wave); if (hi > 2) grid.sync(); }
  if (lo <= 2 && hi > 2) { phase2(p, smem, g_wave); if (hi > 3) grid.sync(); }
  if (lo <= 3 && hi > 3) { phase3(p, smem, g_wave); if (hi > 4) grid.sync(); }
  if (lo <= 4 && hi > 4) { phase4(p, g_wave); }
}

extern "C" void kernel_launch(void* const* d_in, const int* in_sizes, int n_in, void* d_out, int out_size, void* d_ws, size_t ws_size, hipStream_t stream) {
  static int grid_blocks = 0;
  if (!grid_blocks) {
    int dev = 0, cus = 0, per_cu = 0;
    hipGetDevice(&dev);
    hipDeviceGetAttribute(&cus, hipDeviceAttributeMultiprocessorCount, dev);
    hipFuncSetAttribute((const void*)mega, hipFuncAttributeMaxDynamicSharedMemorySize, LDS_BYTES);
    hipOccupancyMaxActiveBlocksPerMultiprocessor(&per_cu, (const void*)mega, 512, LDS_BYTES);
    if (per_cu < 1) per_cu = 1;
    if (per_cu > 1) per_cu = 1;
    grid_blocks = cus * per_cu;
    if (ws_size < WS_TOTAL) fprintf(stderr, "workspace too small: %zu < %zu\n", ws_size, (size_t)WS_END);
  }
  Params p{};
  const float** pp = (const float**)&p;
  for (int i = 0; i < 25; ++i) pp[i] = (const float*)d_in[i];
  p.out = (float*)d_out; p.ws = (char*)d_ws;
#if NLAUNCH == 1
  p.ph_lo = 0; p.ph_hi = 5;
  void* args[] = {&p};
  hipError_t e = hipLaunchCooperativeKernel((const void*)mega, dim3(grid_blocks), dim3(512), args, LDS_BYTES, stream);
  if (e != hipSuccess) fprintf(stderr, "cooperative launch failed: %s (grid %d)\n", hipGetErrorString(e), grid_blocks);
#else
  for (int ph = 0; ph < 5; ++ph) {
    p.ph_lo = ph; p.ph_hi = ph + 1;
    hipLaunchKernelGGL(mega, dim3(grid_blocks), dim3(512), LDS_BYTES, stream, p);
  }
#endif
}
```

```cpp
#include <hip/hip_runtime.h>
#include <hip/hip_cooperative_groups.h>
#include <stdint.h>
#include <stdio.h>
namespace cg = cooperative_groups;

#ifndef NLAUNCH
#define NLAUNCH 1
#endif

typedef unsigned short u16;
typedef unsigned int u32;
using bf16x8 = __attribute__((ext_vector_type(8))) short;
using f32x4 = __attribute__((ext_vector_type(4))) float;
using f32x16 = __attribute__((ext_vector_type(16))) float;
using u32x4 = __attribute__((ext_vector_type(4))) unsigned;
using u32x2 = __attribute__((ext_vector_type(2))) unsigned;

#define DI __device__ __forceinline__
#define LAUNDER_TID(t) int t = (g_wave << 6) | (int)__builtin_amdgcn_mbcnt_hi(~0u, __builtin_amdgcn_mbcnt_lo(~0u, 0u)); asm volatile("" : "+v"(t))

constexpr int TP = 65536, TS = 512, TT = 66048;
constexpr int NINP = 8448;
constexpr int LDS_BYTES = 157696;

constexpr size_t WS_CTR = 0;
constexpr size_t WS_ROPE = 4096;
constexpr size_t WS_WINT = WS_ROPE + 8192 * 16 * 4;
constexpr size_t WS_WOUTT = WS_WINT + (size_t)NINP * 1024 * 2;
constexpr size_t WS_WUPT = WS_WOUTT + (size_t)1024 * 2048 * 2;
constexpr size_t WS_AUPT = WS_WUPT + 1024 * 64 * 2;
constexpr size_t WS_H = WS_AUPT + 1024 * 64 * 2;
constexpr size_t WS_Q = WS_H + (size_t)TT * 1024 * 2;
constexpr size_t WS_K = WS_Q + (size_t)TT * 1024 * 2;
constexpr size_t WS_KC = WS_K + (size_t)TP * 1024 * 2;
constexpr size_t WS_VT = WS_KC + (size_t)8 * 1088 * 1024 * 2;
constexpr size_t WS_VTS = WS_VT + (size_t)TP * 1024 * 2;
constexpr size_t WS_PS = WS_VTS + (size_t)8 * 1088 * 1024 * 2;
constexpr size_t WS_END = WS_PS + (size_t)TT * 3200 * 2;
constexpr size_t WS_TOTAL = WS_END + (size_t)256 * 8 * 16384;

constexpr size_t O_Y = 0;
constexpr size_t O_KP = (size_t)TT * 1024;
constexpr size_t O_VP = O_KP + (size_t)TP * 1024;
constexpr size_t O_WKVP = O_VP + (size_t)TP * 1024;
constexpr size_t O_SHP = O_WKVP + 524288;
constexpr size_t O_KS = O_SHP + 25600;
constexpr size_t O_VS = O_KS + 524288;
constexpr size_t O_WKVS = O_VS + 524288;
constexpr size_t O_SHS = O_WKVS + 524288;

struct Params {
  const float *x_prompt, *x_sample, *cache_k, *cache_v, *state_wkv, *state_shift, *norm_pre, *w_in,
      *lq1, *lk1, *lq2, *lk2, *subln, *mu, *w0, *w_up, *a0, *a_up, *k_k, *k_a, *r_k, *ln_w, *ln_b, *w_out, *norm_post;
  float* out;
  char* ws;
  long ph_lo, ph_hi;
};

DI u16 f2bf(float f) { u32 u = __float_as_uint(f); u += 0x7fffu + ((u >> 16) & 1u); return (u16)(u >> 16); }
DI float bf2f(u16 h) { return __uint_as_float(((u32)h) << 16); }
DI u32 cvtpk(float lo, float hi) { u32 r; asm volatile("v_cvt_pk_bf16_f32 %0, %1, %2" : "=v"(r) : "v"(lo), "v"(hi)); return r; }
DI float wave_sum(float v) { for (int o = 32; o > 0; o >>= 1) v += __shfl_xor(v, o); return v; }
DI float dppf(float x, const int ctrl) { return x; }
#define DPP_ADD(x, ctrl) ((x) + __int_as_float(__builtin_amdgcn_mov_dpp(__float_as_int(x), (ctrl), 0xf, 0xf, true)))
DI float silu(float x) { return x * __builtin_amdgcn_rcpf(1.f + __expf(-x)); }

DI void transpose_tile(const float* src, long sld, u16* dst, long dld, int r0, int c0, float* t, const int g_wave) {
  LAUNDER_TID(tid);
  int a = tid >> 6, l = tid & 63;
  for (int i = 0; i < 8; ++i) t[(a + 8 * i) * 65 + l] = src[(long)(r0 + a + 8 * i) * sld + c0 + l];
  __syncthreads();
  for (int i = 0; i < 8; ++i) dst[(long)(c0 + a + 8 * i) * dld + r0 + l] = f2bf(t[l * 65 + a + 8 * i]);
  __syncthreads();
}

DI void phase0(const Params& p, char* smem, const int g_wave) {
  LAUNDER_TID(tid);
  const int lane = tid & 63, wid = tid >> 6;
  const int gw = blockIdx.x * 8 + wid, nw = gridDim.x * 8;
  const long gt = (long)blockIdx.x * 512 + tid, nt = (long)gridDim.x * 512;
  if (blockIdx.x == 0 && tid == 0) { ((int*)(p.ws + WS_CTR))[0] = 0; }
  {
    float* rope = (float*)(p.ws + WS_ROPE);
    const double invf[8] = {1.0, 0.19392274474868576, 0.03760603093086393, 0.007292664737217109,
                            0.001414213562373095, 0.0002742481756762073, 5.318295896944988e-05, 1.031338537721246e-05};
    for (long i = gt; i < 8192 * 8; i += nt) {
      int pos = (int)(i >> 3), k = (int)(i & 7);
      double iv = k == 0 ? invf[0] : k == 1 ? invf[1] : k == 2 ? invf[2] : k == 3 ? invf[3] : k == 4 ? invf[4] : k == 5 ? invf[5] : k == 6 ? invf[6] : invf[7];
      double x = (double)pos * iv;
      double n = rint(x * 0.15915494309189535);
      double rr = fma(-n, 6.283185307179586, x);
      rr = fma(-n, 2.4492935982947064e-16, rr);
      double x2 = rr * rr;
      double c = 1.0, s = 1.0, tc = 1.0, ts = 1.0;
      for (int m = 1; m <= 14; ++m) {
        tc *= -x2 / (double)((2 * m - 1) * (2 * m));
        ts *= -x2 / (double)((2 * m) * (2 * m + 1));
        c += tc; s += ts;
      }
      s *= rr;
      rope[pos * 16 + k] = (float)c;
      rope[pos * 16 + 8 + k] = (float)s;
    }
  }
  {
    u16* H = (u16*)(p.ws + WS_H);
    for (int row = gw; row < TT; row += nw) {
      const float* x = row < TP ? p.x_prompt + (size_t)row * 1024 : p.x_sample + (size_t)(row - TP) * 1024;
      float4 v[4]; float ss = 0.f;
      for (int i = 0; i < 4; ++i) { v[i] = ((const float4*)x)[lane + 64 * i]; ss += v[i].x * v[i].x + v[i].y * v[i].y + v[i].z * v[i].z + v[i].w * v[i].w; }
      ss = wave_sum(ss);
      float sc = rsqrtf(ss * (1.f / 1024.f) + 1e-6f);
      for (int i = 0; i < 4; ++i) {
        float4 g = ((const float4*)p.norm_pre)[lane + 64 * i];
        u32x2 o; o[0] = cvtpk(v[i].x * sc * g.x, v[i].y * sc * g.y); o[1] = cvtpk(v[i].z * sc * g.z, v[i].w * sc * g.w);
        *(u32x2*)(H + (size_t)row * 1024 + (lane + 64 * i) * 4) = o;
      }
    }
  }
  {
    u16* KC = (u16*)(p.ws + WS_KC);
    for (long i = gt; i < (long)8 * 1024 * 256; i += nt) {
      long e = i * 4; int b = (int)(e >> 20); long rem = e & 1048575;
      float4 v = ((const float4*)p.cache_k)[i];
      u32x2 o; o[0] = cvtpk(v.x, v.y); o[1] = cvtpk(v.z, v.w);
      *(u32x2*)(KC + (size_t)b * 1088 * 1024 + rem) = o;
    }
  }
  {
    u32* Z = (u32*)(p.ws + WS_WINT + (size_t)8320 * 1024 * 2);
    for (long i = gt; i < 128 * 1024 / 2; i += nt) Z[i] = 0u;
  }
  {
    float* t = (float*)smem;
    const int n0 = 16 * 130, n1 = n0 + 32 * 16, n2 = n1 + 16, n3 = n2 + 16, n4 = n3 + 64 * 32;
    for (int j = blockIdx.x; j < n4; j += gridDim.x) {
      if (j < n0) { int rt = j / 130, ct = j % 130; transpose_tile(p.w_in, 8320, (u16*)(p.ws + WS_WINT), 1024, rt * 64, ct * 64, t, g_wave); }
      else if (j < n1) { int q = j - n0; transpose_tile(p.w_out, 1024, (u16*)(p.ws + WS_WOUTT), 2048, (q >> 4) * 64, (q & 15) * 64, t, g_wave); }
      else if (j < n2) { int q = j - n1; transpose_tile(p.w_up, 1024, (u16*)(p.ws + WS_WUPT), 64, 0, q * 64, t, g_wave); }
      else if (j < n3) { int q = j - n2; transpose_tile(p.a_up, 1024, (u16*)(p.ws + WS_AUPT), 64, 0, q * 64, t, g_wave); }
      else { int q = j - n3; int bh = q >> 5, tl = q & 31; int b = bh >> 3, h = bh & 7;
        transpose_tile(p.cache_v + (size_t)b * 1024 * 1024 + h * 128, 1024, (u16*)(p.ws + WS_VTS) + (size_t)bh * 128 * 1088, 1088, (tl >> 1) * 64, (tl & 1) * 64, t, g_wave); }
    }
  }
}

#define LAS __attribute__((address_space(3)))
constexpr int BM = 256, BK = 64, HALF = 128, HTB = HALF * BK * 2;

DI int lds_byte(int r, int c) { const int st = (r >> 4) * 2 + (c >> 5), rr = r & 15, cc = c & 31, ob = rr * 64 + cc * 2; return st * 1024 + (ob ^ (((ob >> 9) & 1) << 5)); }
DI void stage_rc(int b, int& R, int& C) { const int st = b / 1024, sb = b % 1024, swz = sb ^ (((sb >> 9) & 1) << 5); R = (st >> 1) * 16 + swz / 64; C = (st & 1) * 32 + (swz % 64) / 2; }

template <int MODE> DI bool gemm_unit(int i, int& pm, int& pn) {
  if (MODE == 0) {
    const int cc = (blockIdx.x & 7) * 32 + (blockIdx.x >> 3);
    const int v = i * 256 + cc;
    if (v >= 258 * 33) return false;
    const int g = v / 264;
    if (g < 32) { const int r = v - g * 264; pm = g * 8 + (r & 7); pn = r >> 3; }
    else { const int r = v - 32 * 264; pm = 256 + (r & 1); pn = r >> 1; }
    return true;
  } else {
    const int v = i * 256 + blockIdx.x;
    if (v >= 258 * 4) return false;
    pm = v >> 2; pn = v & 3; return true;
  }
}

DI int perm32(int rho) { const int n = rho >> 4, i = rho & 15; return 8 * (i >> 2) + 4 * n + (i & 3); }
template <int MODE>
DI void gemm_epilogue(const Params& p, const f32x4 (&acc)[2][2][4][2], int pm, int pn, int wr, int wc, int fr, int fq) {
  const int brow = pm * BM, bcol = pn * BM;
  if (MODE == 1) {
    float* C = p.out + O_Y;
#pragma unroll
    for (int ai = 0; ai < 2; ++ai)
#pragma unroll
      for (int m = 0; m < 4; ++m) {
        float* rowp = C + (size_t)(brow + ai * HALF + wr * 64 + m * 16 + fr) * 1024 + bcol + wc * 32 + 8 * fq;
#pragma unroll
        for (int bj = 0; bj < 2; ++bj) { *(f32x4*)(rowp + bj * HALF) = acc[ai][bj][m][0]; *(f32x4*)(rowp + bj * HALF + 4) = acc[ai][bj][m][1]; }
      }
  } else {
    const bool prompt = brow < TP;
    const float* rope = (const float*)(p.ws + WS_ROPE);
#pragma unroll
    for (int bj = 0; bj < 2; ++bj) {
      const int cb = bcol + bj * HALF;
      if (cb >= 8320) continue;
#pragma unroll
      for (int ai = 0; ai < 2; ++ai)
#pragma unroll
        for (int m = 0; m < 4; ++m) {
          const int row = brow + ai * HALF + wr * 64 + m * 16 + fr;
          f32x4 va = acc[ai][bj][m][0], vb = acc[ai][bj][m][1];
          const int col = cb + wc * 32 + 8 * fq;
          if (cb < 2048) {
            if ((wc & 1) == 0) {
              const int pos = prompt ? (row & 8191) : 1024 + (row & 63);
              const f32x4 c0 = *(const f32x4*)(rope + pos * 16), c1 = *(const f32x4*)(rope + pos * 16 + 4);
              const f32x4 s0 = *(const f32x4*)(rope + pos * 16 + 8), s1 = *(const f32x4*)(rope + pos * 16 + 12);
              f32x4 pa, pb;
#pragma unroll
              for (int j = 0; j < 4; ++j) { pa[j] = __shfl_xor(va[j], 16); pb[j] = __shfl_xor(vb[j], 16); }
              if (fq == 0) { for (int j = 0; j < 4; ++j) { va[j] = va[j] * c0[j] - pa[j] * s0[j]; vb[j] = vb[j] * c1[j] - pb[j] * s1[j]; } }
              else if (fq == 1) { for (int j = 0; j < 4; ++j) { va[j] = va[j] * c0[j] + pa[j] * s0[j]; vb[j] = vb[j] * c1[j] + pb[j] * s1[j]; } }
            }
            u32x4 pk = {cvtpk(va[0], va[1]), cvtpk(va[2], va[3]), cvtpk(vb[0], vb[1]), cvtpk(vb[2], vb[3])};
            if (cb < 1024) {
              *(u32x4*)((u16*)(p.ws + WS_Q) + (size_t)row * 1024 + col) = pk;
            } else {
              const int c = col - 1024;
              if (prompt) {
                float* ko = p.out + O_KP + (size_t)row * 1024 + c; *(f32x4*)ko = va; *(f32x4*)(ko + 4) = vb;
                *(u32x4*)((u16*)(p.ws + WS_K) + (size_t)row * 1024 + c) = pk;
              } else {
                const int rs = row - TP, b = rs >> 6, t = rs & 63;
                float* ko = p.out + O_KS + (size_t)rs * 1024 + c; *(f32x4*)ko = va; *(f32x4*)(ko + 4) = vb;
                *(u32x4*)((u16*)(p.ws + WS_KC) + ((size_t)b * 1088 + 1024 + t) * 1024 + c) = pk;
              }
            }
          } else if (cb < 3072) {
            const int c = col - 2048, h = c >> 7, dv = c & 127;
            if (prompt) {
              float* vo = p.out + O_VP + (size_t)row * 1024 + c; *(f32x4*)vo = va; *(f32x4*)(vo + 4) = vb;
              const int b = row >> 13, t = row & 8191;
              u16* vt = (u16*)(p.ws + WS_VT) + ((size_t)(b * 8 + h) * 128 + dv) * 8192 + t;
#pragma unroll
              for (int j = 0; j < 4; ++j) { vt[(size_t)j * 8192] = f2bf(va[j]); vt[(size_t)(j + 4) * 8192] = f2bf(vb[j]); }
            } else {
              const int rs = row - TP, b = rs >> 6, t = rs & 63;
              float* vo = p.out + O_VS + (size_t)rs * 1024 + c; *(f32x4*)vo = va; *(f32x4*)(vo + 4) = vb;
              u16* vt = (u16*)(p.ws + WS_VTS) + ((size_t)(b * 8 + h) * 128 + dv) * 1088 + 1024 + t;
#pragma unroll
              for (int j = 0; j < 4; ++j) { vt[(size_t)j * 1088] = f2bf(va[j]); vt[(size_t)(j + 4) * 1088] = f2bf(vb[j]); }
            }
          } else {
            u32x4 pk = {cvtpk(va[0], va[1]), cvtpk(va[2], va[3]), cvtpk(vb[0], vb[1]), cvtpk(vb[2], vb[3])};
            if (cb < 4096) {
              *(u32x4*)((u16*)(p.out + O_Y) + (size_t)row * 1024 + (col - 3072)) = pk;
            } else if (cb < 7296) {
              const int c = col - 4096;
              *(u32x4*)((u16*)(p.ws + WS_PS) + (size_t)row * 3200 + c) = pk;
              if (prompt) { if ((row & 8191) == 8191) { float* so = p.out + O_SHP + (size_t)(row >> 13) * 3200 + c; *(f32x4*)so = va; *(f32x4*)(so + 4) = vb; } }
              else { if ((row & 63) == 63) { float* so = p.out + O_SHS + (size_t)((row - TP) >> 6) * 3200 + c; *(f32x4*)so = va; *(f32x4*)(so + 4) = vb; } }
            } else {
              *(u32x4*)((u16*)(p.out + O_Y) + (size_t)TT * 1024 + (size_t)row * 1024 + (col - 7296)) = pk;
            }
          }
        }
    }
  }
}

template <int MODE>
DI void gemm_phase(const Params& p, char* smem, const int g_wave) {
  constexpr int K = MODE == 0 ? 1024 : 2048, nt = K / BK;
  LAS unsigned char* lds = (LAS unsigned char*)smem;
  LAUNDER_TID(tid);
  const int wid = __builtin_amdgcn_readfirstlane(tid >> 6), lane = tid & 63, wr = wid >> 2, wc = wid & 3, fr = lane & 15, fq = lane >> 4;
  unsigned voffA0[2], voffA1[2], voffB[2];
#pragma unroll
  for (int i = 0; i < 2; ++i) { int R, C; stage_rc(tid * 16 + i * 8192, R, C);
    const int Rb = (R & ~31) + perm32(R & 31);
    voffA0[i] = (unsigned)(R * 1024 + C) * 2u; voffA1[i] = (unsigned)(R * 3200 + C) * 2u; voffB[i] = (unsigned)(Rb * K + C) * 2u; }
  const unsigned ldsw = (unsigned)wid * 1024u;
  const int aoff = lds_byte(wr * 64 + fr, fq * 8), boff = lds_byte(wc * 32 + fr, fq * 8);
  const char* Bbase = p.ws + (MODE == 0 ? WS_WINT : WS_WOUTT);
#define G_SA(b, h) (((b) * 2 + (h)) * HTB)
#define G_SB(b, h) ((4 + (b) * 2 + (h)) * HTB)
#define G_STAGE_B(bufoff, upn, kt_, h_) do { const char* _g = Bbase + ((size_t)((upn) * 256 + (h_) * 128) * K + (size_t)(kt_) * 64) * 2; \
    _Pragma("unroll") for (int _i = 0; _i < 2; ++_i) \
      __builtin_amdgcn_global_load_lds((const unsigned*)(_g + voffB[_i]), (LAS unsigned*)(lds + (bufoff) + ldsw + _i * 8192), 16, 0, 0); } while (0)
#define G_STAGE_A(bufoff, upm, kt_, h_) do { \
    if (MODE == 0 || (kt_) < 16) { const char* _g = p.ws + (MODE == 0 ? WS_H : WS_Q) + ((size_t)((upm) * 256 + (h_) * 128) * 1024 + (size_t)(kt_) * 64) * 2; \
      _Pragma("unroll") for (int _i = 0; _i < 2; ++_i) \
        __builtin_amdgcn_global_load_lds((const unsigned*)(_g + voffA0[_i]), (LAS unsigned*)(lds + (bufoff) + ldsw + _i * 8192), 16, 0, 0); } \
    else { const char* _g = p.ws + WS_PS + ((size_t)((upm) * 256 + (h_) * 128) * 3200 + (size_t)((kt_) - 16) * 64) * 2; \
      _Pragma("unroll") for (int _i = 0; _i < 2; ++_i) \
        __builtin_amdgcn_global_load_lds((const unsigned*)(_g + voffA1[_i]), (LAS unsigned*)(lds + (bufoff) + ldsw + _i * 8192), 16, 0, 0); } } while (0)
#define G_LDA(dst, b, h) do { _Pragma("unroll") for (int m = 0; m < 4; ++m) _Pragma("unroll") for (int k = 0; k < 2; ++k) dst[m][k] = *(const LAS bf16x8*)(lds + G_SA(b, h) + aoff + m * 2048 + k * 1024); } while (0)
#define G_LDB(dst, b, h) do { _Pragma("unroll") for (int n = 0; n < 2; ++n) _Pragma("unroll") for (int k = 0; k < 2; ++k) dst[n][k] = *(const LAS bf16x8*)(lds + G_SB(b, h) + boff + n * 2048 + k * 1024); } while (0)
#define G_MMA(ai, bj, At, Bt_) do { __builtin_amdgcn_s_setprio(1); _Pragma("unroll") for (int m = 0; m < 4; ++m) _Pragma("unroll") for (int n = 0; n < 2; ++n) _Pragma("unroll") for (int k = 0; k < 2; ++k) \
    acc[ai][bj][m][n] = __builtin_amdgcn_mfma_f32_16x16x32_bf16(Bt_[n][k], At[m][k], acc[ai][bj][m][n], 0, 0, 0); __builtin_amdgcn_s_setprio(0); } while (0)
#define G_WAIT_V(n) asm volatile("s_waitcnt vmcnt(" #n ")" ::: "memory")
#define G_WAIT_L(n) asm volatile("s_waitcnt lgkmcnt(" #n ")" ::: "memory")
#define G_BAR __builtin_amdgcn_s_barrier()
#define G_SCHED __builtin_amdgcn_sched_barrier(0)
  int cpm, cpn, npm = 0, npn = 0, ui = 0;
  if (!gemm_unit<MODE>(0, cpm, cpn)) return;
  f32x4 acc[2][2][4][2];
#pragma unroll
  for (int a = 0; a < 2; ++a)
#pragma unroll
    for (int b = 0; b < 2; ++b)
#pragma unroll
      for (int m = 0; m < 4; ++m)
#pragma unroll
        for (int n = 0; n < 2; ++n) acc[a][b][m][n] = (f32x4){0.f, 0.f, 0.f, 0.f};
  bf16x8 At[4][2], B0[2][2], B1[2][2];
  G_STAGE_B(G_SB(0, 0), cpn, 0, 0); G_STAGE_A(G_SA(0, 0), cpm, 0, 0); G_STAGE_B(G_SB(0, 1), cpn, 0, 1); G_STAGE_A(G_SA(0, 1), cpm, 0, 1);
  if (wr == 1) G_BAR;
  G_WAIT_V(4); G_BAR;
  G_STAGE_B(G_SB(1, 0), cpn, 1, 0); G_STAGE_A(G_SA(1, 0), cpm, 1, 0); G_STAGE_B(G_SB(1, 1), cpn, 1, 1);
  G_WAIT_V(6); G_BAR;
  for (;;) {
    const bool has_next = gemm_unit<MODE>(ui + 1, npm, npn);
    if (!has_next) { npm = cpm; npn = cpn; }
#pragma unroll 1
    for (int t = 0; t < nt; t += 2) {
      const bool last = (t == nt - 2);
      const int pm2 = last ? npm : cpm, pn2 = last ? npn : cpn, t2 = last ? 0 : t + 2, t3 = t2 + 1;
      G_LDB(B0, 0, 0); G_SCHED; G_LDA(At, 0, 0); G_STAGE_A(G_SA(1, 1), cpm, t + 1, 1);
      G_WAIT_L(8); G_BAR; G_WAIT_L(0); G_MMA(0, 0, At, B0); G_BAR; G_SCHED;
      G_LDB(B1, 0, 1); G_STAGE_B(G_SB(0, 0), pn2, t2, 0);
      G_BAR; G_WAIT_L(0); G_MMA(0, 1, At, B1); G_BAR;
      G_LDA(At, 0, 1); G_STAGE_A(G_SA(0, 0), pm2, t2, 0);
      G_BAR; G_WAIT_L(0); G_MMA(1, 0, At, B0); G_BAR; G_SCHED;
      G_STAGE_B(G_SB(0, 1), pn2, t2, 1);
      G_WAIT_V(6); G_BAR; G_MMA(1, 1, At, B1); G_BAR;
      G_LDB(B0, 1, 0); G_SCHED; G_LDA(At, 1, 0); G_STAGE_A(G_SA(0, 1), pm2, t2, 1);
      G_WAIT_L(8); G_BAR; G_WAIT_L(0); G_MMA(0, 0, At, B0); G_BAR; G_SCHED;
      G_LDB(B1, 1, 1); G_STAGE_B(G_SB(1, 0), pn2, t3, 0);
      G_BAR; G_WAIT_L(0); G_MMA(0, 1, At, B1); G_BAR;
      G_LDA(At, 1, 1); G_STAGE_A(G_SA(1, 0), pm2, t3, 0);
      G_BAR; G_WAIT_L(0); G_MMA(1, 0, At, B0); G_BAR; G_SCHED;
      G_STAGE_B(G_SB(1, 1), pn2, t3, 1);
      G_WAIT_V(6); G_BAR; G_MMA(1, 1, At, B1); G_BAR;
    }
    gemm_epilogue<MODE>(p, acc, cpm, cpn, wr, wc, fr, fq);
    if (!has_next) break;
#pragma unroll
    for (int a = 0; a < 2; ++a)
#pragma unroll
      for (int b = 0; b < 2; ++b)
#pragma unroll
        for (int m = 0; m < 4; ++m)
#pragma unroll
          for (int n = 0; n < 2; ++n) acc[a][b][m][n] = (f32x4){0.f, 0.f, 0.f, 0.f};
    cpm = npm; cpn = npn; ++ui;
  }
  G_WAIT_V(0);
  if (wr == 0) G_BAR;
  G_BAR;
#undef G_SA
#undef G_SB
#undef G_STAGE_A
#undef G_STAGE_B
#undef G_LDA
#undef G_LDB
#undef G_MMA
}

DI void phase1(const Params& p, char* smem, const int g_wave) { gemm_phase<0>(p, smem, g_wave); }
DI void phase3(const Params& p, char* smem, const int g_wave) { gemm_phase<1>(p, smem, g_wave); }

constexpr int KBUF = 64 * 256, VBUF = 128 * 128, QWAVE = 32 * 272;

DI void attn_item(const Params& p, char* smem, u16* qbase, const u16* gabase, const u16* kbase, const u16* vtbase,
                  int tkv, int nkt, int mylimit, const float* lam_p, const int g_wave) {
  LAUNDER_TID(tid);
  const int lane = tid & 63, wid = __builtin_amdgcn_readfirstlane(tid >> 6), r = lane & 31, hh = lane >> 5;
  constexpr float C = 0.125f * 1.4426950408889634f;
  LAS unsigned char* lds = (LAS unsigned char*)smem;
  char* Kb = smem; char* Vb = smem + 2 * KBUF; char* Qs = smem + 2 * KBUF + 2 * VBUF + wid * QWAVE;
  if (mylimit > 0) {
#pragma unroll
    for (int i = 0; i < 8; ++i) { const int id = i * 64 + lane, row = id >> 4, cc = id & 15;
      *(uint4*)(Qs + row * 272 + cc * 16) = *(const uint4*)(qbase + (size_t)(wid * 32 + row) * 1024 + cc * 8); }
  }
  unsigned kso[2], vso[2];
#pragma unroll
  for (int i = 0; i < 2; ++i) {
    const int krow = 4 * (2 * wid + i) + (lane >> 4), kpos = lane & 15;
    kso[i] = (unsigned)(krow * 1024 + ((kpos ^ (krow & 15)) * 8)) * 2u;
    const int vrow = 8 * (2 * wid + i) + (lane >> 3), vpos = lane & 7;
    vso[i] = (unsigned)(vrow * tkv + ((vpos ^ ((vrow >> 1) & 7)) * 8)) * 2u;
  }
#define STAGE_KV(buf, kt) do { const char* kb_ = (const char*)kbase + (size_t)(kt) * 131072; const char* vb_ = (const char*)vtbase + (size_t)(kt) * 128; \
    _Pragma("unroll") for (int i = 0; i < 2; ++i) { \
      __builtin_amdgcn_global_load_lds((const unsigned*)(kb_ + kso[i]), (LAS unsigned*)(lds + (buf) * KBUF + (2 * wid + i) * 1024), 16, 0, 0); \
      __builtin_amdgcn_global_load_lds((const unsigned*)(vb_ + vso[i]), (LAS unsigned*)(lds + 2 * KBUF + (buf) * VBUF + (2 * wid + i) * 1024), 16, 0, 0); } } while (0)
  f32x16 O0[4], O1[4];
#pragma unroll
  for (int d = 0; d < 4; ++d) { O0[d] = f32x16{}; O1[d] = f32x16{}; }
  float l0 = 0.f, l1 = 0.f, m0 = -1e30f, m1 = -1e30f;
#define SOFTMAX_COMP(cidx, LREG, MREG, OARR, PF) do { \
      f32x16 s0 = f32x16{}, s1 = f32x16{}; \
      _Pragma("unroll") for (int s = 0; s < 4; ++s) { \
        const int ch = (cidx) * 8 + s * 2 + hh; \
        const bf16x8 qf = *(const bf16x8*)(Qk + r * 272 + ((cidx) * 64 + s * 16 + hh * 8) * 2); \
        const bf16x8 ka = *(const bf16x8*)(Kt + r * 256 + ((ch * 16) ^ kz)); \
        const bf16x8 kb = *(const bf16x8*)(Kt + (32 + r) * 256 + ((ch * 16) ^ kz)); \
        s0 = __builtin_amdgcn_mfma_f32_32x32x16_bf16(ka, qf, s0, 0, 0, 0); \
        s1 = __builtin_amdgcn_mfma_f32_32x32x16_bf16(kb, qf, s1, 0, 0, 0); } \
      float tm = s0[0]; \
      _Pragma("unroll") for (int i = 1; i < 16; ++i) tm = fmaxf(tm, s0[i]); \
      _Pragma("unroll") for (int i = 0; i < 16; ++i) tm = fmaxf(tm, s1[i]); \
      { auto rr = __builtin_amdgcn_permlane32_swap(__float_as_uint(tm), __float_as_uint(tm), false, false); \
        tm = fmaxf(__uint_as_float(rr[0]), __uint_as_float(rr[1])); } \
      tm *= C; \
      if (!__all(tm <= MREG + 8.f)) { \
        const float mn = fmaxf(MREG, tm); const float sc = __builtin_amdgcn_exp2f(MREG - mn); \
        MREG = mn; LREG *= sc; \
        _Pragma("unroll") for (int d = 0; d < 4; ++d) _Pragma("unroll") for (int i = 0; i < 16; ++i) OARR[d][i] *= sc; } \
      const float mneg = -MREG; float ps = 0.f; \
      _Pragma("unroll") for (int i = 0; i < 16; ++i) { s0[i] = __builtin_amdgcn_exp2f(fmaf(s0[i], C, mneg)); ps += s0[i]; } \
      _Pragma("unroll") for (int i = 0; i < 16; ++i) { s1[i] = __builtin_amdgcn_exp2f(fmaf(s1[i], C, mneg)); ps += s1[i]; } \
      LREG += ps; \
      _Pragma("unroll") for (int s = 0; s < 2; ++s) { \
        u32x4 w0 = {cvtpk(s0[8 * s + 0], s0[8 * s + 1]), cvtpk(s0[8 * s + 2], s0[8 * s + 3]), cvtpk(s0[8 * s + 4], s0[8 * s + 5]), cvtpk(s0[8 * s + 6], s0[8 * s + 7])}; \
        u32x4 w1 = {cvtpk(s1[8 * s + 0], s1[8 * s + 1]), cvtpk(s1[8 * s + 2], s1[8 * s + 3]), cvtpk(s1[8 * s + 4], s1[8 * s + 5]), cvtpk(s1[8 * s + 6], s1[8 * s + 7])}; \
        PF[s] = *reinterpret_cast<bf16x8*>(&w0); PF[2 + s] = *reinterpret_cast<bf16x8*>(&w1); } } while (0)

  STAGE_KV(0, 0);
  asm volatile("s_waitcnt vmcnt(0)" ::: "memory");
  __syncthreads();
#pragma unroll 1
  for (int kt = 0; kt < nkt; ++kt) {
    if (kt + 1 < nkt) STAGE_KV((kt + 1) & 1, kt + 1);
    if (kt < mylimit) {
      const char* Kt = Kb + (kt & 1) * KBUF;
      const char* Vt = Vb + (kt & 1) * VBUF;
      int zq = 0, kz = (r & 15) * 16, vz = ((r >> 1) & 7) * 16;
      asm volatile("" : "+v"(zq), "+v"(kz), "+v"(vz));
      const char* Qk = Qs + zq;
      bf16x8 pf0[4], pf1[4];
      SOFTMAX_COMP(0, l0, m0, O0, pf0);
      __builtin_amdgcn_sched_barrier(0);
      SOFTMAX_COMP(1, l1, m1, O1, pf1);
      __builtin_amdgcn_sched_barrier(0);
#pragma unroll
      for (int d = 0; d < 4; ++d) {
        const int vrow = 32 * d + r;
#pragma unroll
        for (int sp = 0; sp < 4; ++sp) {
          const u32x2 lo = *(const u32x2*)(Vt + vrow * 128 + ((32 * sp) ^ vz) + 8 * hh);
          const u32x2 hi = *(const u32x2*)(Vt + vrow * 128 + ((32 * sp + 16) ^ vz) + 8 * hh);
          u32x4 w = {lo[0], lo[1], hi[0], hi[1]};
          const bf16x8 vf = *reinterpret_cast<bf16x8*>(&w);
          O0[d] = __builtin_amdgcn_mfma_f32_32x32x16_bf16(vf, pf0[sp], O0[d], 0, 0, 0);
          O1[d] = __builtin_amdgcn_mfma_f32_32x32x16_bf16(vf, pf1[sp], O1[d], 0, 0, 0);
        }
        __builtin_amdgcn_sched_barrier(0);
      }
    }
    asm volatile("s_waitcnt vmcnt(0)" ::: "memory");
    __syncthreads();
  }
#undef STAGE_KV
#undef SOFTMAX_COMP
  if (mylimit > 0) {
    LAUNDER_TID(tid2);
    const int lane = tid2 & 63, wid = tid2 >> 6, r = lane & 31, hh = lane >> 5;
    u16* qrow = qbase + (size_t)(wid * 32 + r) * 1024;
    { auto rr = __builtin_amdgcn_permlane32_swap(__float_as_uint(l0), __float_as_uint(l0), false, false);
      l0 = __uint_as_float(rr[0]) + __uint_as_float(rr[1]); }
    { auto rr = __builtin_amdgcn_permlane32_swap(__float_as_uint(l1), __float_as_uint(l1), false, false);
      l1 = __uint_as_float(rr[0]) + __uint_as_float(rr[1]); }
    const float i0 = 1.f / l0, i1 = *lam_p / l1;
    float ss = 0.f;
#pragma unroll
    for (int d = 0; d < 4; ++d)
#pragma unroll
      for (int i = 0; i < 16; ++i) { float v = O0[d][i] * i0 - O1[d][i] * i1; O0[d][i] = v; ss += v * v; }
    { auto rr = __builtin_amdgcn_permlane32_swap(__float_as_uint(ss), __float_as_uint(ss), false, false);
      ss = __uint_as_float(rr[0]) + __uint_as_float(rr[1]); }
    const float rs = rsqrtf(ss * (1.f / 128.f) + 1e-5f) * 0.8f;
    const u16* garow = gabase + (size_t)(wid * 32 + r) * 1024;
#pragma unroll
    for (int d = 0; d < 4; ++d)
#pragma unroll
      for (int g = 0; g < 4; ++g) {
        int dv = 32 * d + 8 * g + 4 * hh;
        u32x2 gg = *(const u32x2*)(garow + dv);
        float4 sl = *(const float4*)(p.subln + dv);
        float g0 = __uint_as_float(gg[0] << 16), g1 = __uint_as_float(gg[0] & 0xffff0000u), g2 = __uint_as_float(gg[1] << 16), g3 = __uint_as_float(gg[1] & 0xffff0000u);
        float o0 = O0[d][4 * g + 0] * rs * sl.x * silu(g0);
        float o1 = O0[d][4 * g + 1] * rs * sl.y * silu(g1);
        float o2 = O0[d][4 * g + 2] * rs * sl.z * silu(g2);
        float o3 = O0[d][4 * g + 3] * rs * sl.w * silu(g3);
        u32x2 o; o[0] = cvtpk(o0, o1); o[1] = cvtpk(o2, o3);
        *(u32x2*)(qrow + dv) = o;
      }
  }
}

DI void Yreg_store(float* Y, int idx, float y) { Y[idx] = y; }
DI void scan_item(const Params& p, char* smem, int b, int h, bool prompt, const int g_wave) {
  LAUNDER_TID(tid);
  const int lane = tid & 63, wid = g_wave;
  constexpr int SETB = 57728;
  constexpr int O_AWD = 2 * SETB, O_AAD = O_AWD + 4608, O_CARRY = O_AAD + 4608, O_CST = O_CARRY + 1280, O_WL = O_CST + 3072;
  float* carry = (float*)(smem + O_CARRY);
  float* cst = (float*)(smem + O_CST);
  char* WL = smem + O_WL;
  u16* PS = (u16*)(p.ws + WS_PS);
  const u16* GB = (const u16*)(p.out + O_Y) + (size_t)TT * 1024;
  const size_t row0 = prompt ? (size_t)b * 8192 : (size_t)TP + b * 64;
  const int nch = prompt ? 256 : 2;
  for (int i = tid; i < 768; i += 512) {
    float cv;
    if (i < 320) { int seg = i >> 6, cc = i & 63; int col = seg < 3 ? seg * 1024 + h * 64 + cc : 3072 + (seg - 3) * 64 + cc; cv = p.mu[col];
      carry[i] = prompt ? 0.f : p.state_shift[(size_t)b * 3200 + col]; }
    else { int idx = i - 320, which = idx >> 6, cc = h * 64 + (idx & 63);
      const float* src = which == 0 ? p.w0 : which == 1 ? p.a0 : which == 2 ? p.k_k : which == 3 ? p.k_a : which == 4 ? p.r_k : which == 5 ? p.ln_w : p.ln_b;
      cv = src[cc]; }
    cst[i] = cv;
  }
  for (int id = tid; id < 1024; id += 512) {
    const int mt = id >> 9, row = (id >> 3) & 63, cc = id & 7;
    *(uint4*)(WL + mt * 9216 + row * 144 + cc * 16) = *(const uint4*)((const u16*)(p.ws + (mt == 0 ? WS_WUPT : WS_AUPT)) + (size_t)(h * 64 + row) * 64 + cc * 8);
  }
  __syncthreads();

  if (wid < 4) {
    typedef float f32x2 __attribute__((ext_vector_type(2)));
    typedef float f32x4v __attribute__((ext_vector_type(4)));
    const int li = lane & 15, g = lane >> 4, irow = wid * 16 + li;
    f32x2 S0[4], S1[4];
    if (prompt) { for (int e = 0; e < 4; ++e) { S0[e] = (f32x2){0.f, 0.f}; S1[e] = (f32x2){0.f, 0.f}; } }
    else {
      const float* s0 = p.state_wkv + ((size_t)(b * 16 + h) * 64 + irow) * 64 + 8 * g;
      for (int e = 0; e < 4; ++e) { S0[e] = (f32x2){s0[2 * e], s0[2 * e + 1]}; S1[e] = (f32x2){s0[32 + 2 * e], s0[32 + 2 * e + 1]}; }
    }
    const int abf_off = ((lane & 3) == 1 ? 12288 : 8192) + 16 * g;
    __syncthreads();
#pragma unroll 1
    for (int k = 0; k < nch; ++k) {
      const char* set = smem + (k & 1) * SETB;
      const float* bW = (const float*)set + 8 * g;
      const char* bA = set + abf_off;
      const float* bV = (const float*)(set + 40960) + irow;
      float* Yp = (float*)(set + 49152) + irow;
      const float2* BK = (const float2*)(set + 57472);
#define LOADV(X, t) do { \
        X##w0 = *(const f32x4v*)(bW + (t) * 64); X##w1 = *(const f32x4v*)(bW + (t) * 64 + 4); X##w2 = *(const f32x4v*)(bW + (t) * 64 + 32); X##w3 = *(const f32x4v*)(bW + (t) * 64 + 36); \
        X##b0 = *(const f32x4v*)(bW + 4096 + (t) * 64); X##b1 = *(const f32x4v*)(bW + 4096 + (t) * 64 + 4); X##b2 = *(const f32x4v*)(bW + 4096 + (t) * 64 + 32); X##b3 = *(const f32x4v*)(bW + 4096 + (t) * 64 + 36); \
        X##k0 = *(const f32x4v*)(bW + 6144 + (t) * 64); X##k1 = *(const f32x4v*)(bW + 6144 + (t) * 64 + 4); X##k2 = *(const f32x4v*)(bW + 6144 + (t) * 64 + 32); X##k3 = *(const f32x4v*)(bW + 6144 + (t) * 64 + 36); \
        X##a0 = *(const bf16x8*)(bA + (t) * 128); X##a1 = *(const bf16x8*)(bA + (t) * 128 + 64); \
        X##v = bV[(t) * 64]; X##s = BK[t]; } while (0)
#define LO2(x) __builtin_shufflevector(x, x, 0, 1)
#define HI2(x) __builtin_shufflevector(x, x, 2, 3)
#define FMA2 __builtin_elementwise_fma
#define STEP(X, t) do { \
        u32x4 c0 = {cvtpk(S0[0].x, S0[0].y), cvtpk(S0[1].x, S0[1].y), cvtpk(S0[2].x, S0[2].y), cvtpk(S0[3].x, S0[3].y)}; \
        u32x4 c1 = {cvtpk(S1[0].x, S1[0].y), cvtpk(S1[1].x, S1[1].y), cvtpk(S1[2].x, S1[2].y), cvtpk(S1[3].x, S1[3].y)}; \
        f32x4 acc = {0.f, 0.f, 0.f, 0.f}; \
        acc = __builtin_amdgcn_mfma_f32_16x16x32_bf16(X##a0, *reinterpret_cast<bf16x8*>(&c0), acc, 0, 0, 0); \
        acc = __builtin_amdgcn_mfma_f32_16x16x32_bf16(X##a1, *reinterpret_cast<bf16x8*>(&c1), acc, 0, 0, 0); \
        const float sa = acc[0]; \
        const f32x2 sav = {sa, sa}, vv = {X##v, X##v}; \
        S0[0] = FMA2(S0[0], LO2(X##w0), FMA2(sav, LO2(X##b0), vv * LO2(X##k0))); S0[1] = FMA2(S0[1], HI2(X##w0), FMA2(sav, HI2(X##b0), vv * HI2(X##k0))); \
        S0[2] = FMA2(S0[2], LO2(X##w1), FMA2(sav, LO2(X##b1), vv * LO2(X##k1))); S0[3] = FMA2(S0[3], HI2(X##w1), FMA2(sav, HI2(X##b1), vv * HI2(X##k1))); \
        S1[0] = FMA2(S1[0], LO2(X##w2), FMA2(sav, LO2(X##b2), vv * LO2(X##k2))); S1[1] = FMA2(S1[1], HI2(X##w2), FMA2(sav, HI2(X##b2), vv * HI2(X##k2))); \
        S1[2] = FMA2(S1[2], LO2(X##w3), FMA2(sav, LO2(X##b3), vv * LO2(X##k3))); S1[3] = FMA2(S1[3], HI2(X##w3), FMA2(sav, HI2(X##b3), vv * HI2(X##k3))); \
        const float y = fmaf(sa, X##s.x, fmaf(X##v, X##s.y, acc[1])); \
        Yp[(t) * 64] = y; } while (0)
      f32x4v Pw0, Pw1, Pw2, Pw3, Pb0, Pb1, Pb2, Pb3, Pk0, Pk1, Pk2, Pk3; bf16x8 Pa0, Pa1; float Pv; float2 Ps;
      f32x4v Qw0, Qw1, Qw2, Qw3, Qb0, Qb1, Qb2, Qb3, Qk0, Qk1, Qk2, Qk3; bf16x8 Qa0, Qa1; float Qv; float2 Qs;
      LOADV(P, 0);
#pragma unroll 1
      for (int t = 0; t < 32; t += 2) {
        LOADV(Q, t + 1);
        STEP(P, t);
        LOADV(P, t + 2);
        STEP(Q, t + 1);
      }
#undef LOADV
#undef STEP
      asm volatile("s_waitcnt lgkmcnt(0)" ::: "memory");
      __builtin_amdgcn_s_barrier();
      asm volatile("" ::: "memory");
    }
    float* so = p.out + (prompt ? O_WKVP : O_WKVS) + ((size_t)(b * 16 + h) * 64 + irow) * 64 + 8 * g;
    *(float4*)so = make_float4(S0[0].x, S0[0].y, S0[1].x, S0[1].y); *(float4*)(so + 4) = make_float4(S0[2].x, S0[2].y, S0[3].x, S0[3].y);
    *(float4*)(so + 32) = make_float4(S1[0].x, S1[0].y, S1[1].x, S1[1].y); *(float4*)(so + 36) = make_float4(S1[2].x, S1[2].y, S1[3].x, S1[3].y);
#undef LO2
#undef HI2
#undef FMA2
  } else {
    const int pw = wid - 4, tl = lane >> 3, sub = lane & 7, tA = pw * 8 + tl;
    u16* Awd = (u16*)(smem + O_AWD); u16* Aad = (u16*)(smem + O_AAD);
    u32x4 cur[5], prv[5], gg;
    float c_mu[5][8], c_kk[8], c_ka[8], c_rk[8], c_w0[4], c_a0[4];
#pragma unroll
    for (int e = 0; e < 8; ++e) {
#pragma unroll
      for (int seg = 0; seg < 5; ++seg) c_mu[seg][e] = cst[seg * 64 + sub * 8 + e];
      c_kk[e] = cst[448 + sub * 8 + e]; c_ka[e] = cst[512 + sub * 8 + e]; c_rk[e] = cst[576 + sub * 8 + e];
    }
#pragma unroll
    for (int nt = 0; nt < 2; ++nt) { const int nn = 16 * ((lane >= 32 ? 2 : 0) + nt) + (lane & 15); c_w0[nt] = cst[320 + nn]; c_a0[nt] = cst[384 + nn]; }
#define PS_COL(seg) ((seg) < 3 ? (seg) * 1024 + h * 64 + sub * 8 : 3072 + ((seg) - 3) * 64 + sub * 8)
#define PREFETCH(ch_) do { const size_t rb_ = row0 + (size_t)(ch_) * 32 + tA; \
      _Pragma("unroll") for (int seg = 0; seg < 5; ++seg) { \
        cur[seg] = *(const u32x4*)(PS + rb_ * 3200 + PS_COL(seg)); \
        if ((ch_) > 0 || tA > 0) prv[seg] = *(const u32x4*)(PS + (rb_ - 1) * 3200 + PS_COL(seg)); } } while (0)
#define PREP_ABC(ch_) do { \
      char* set = smem + ((ch_) & 1) * SETB; \
      float* W = (float*)set; float* A = W + 2048; float* B = W + 4096; float* Kp = W + 6144; float* R = W + 8192; float* V = W + 10240; \
      float* bonus = (float*)(set + 57344); float2* BRKR = (float2*)(set + 57472); \
      _Pragma("unroll") for (int seg = 0; seg < 5; ++seg) { \
        float cf[8], pf_[8]; \
        _Pragma("unroll") for (int e = 0; e < 4; ++e) { cf[2 * e] = __uint_as_float(cur[seg][e] << 16); cf[2 * e + 1] = __uint_as_float(cur[seg][e] & 0xffff0000u); } \
        if ((ch_) > 0 || tA > 0) { \
          _Pragma("unroll") for (int e = 0; e < 4; ++e) { pf_[2 * e] = __uint_as_float(prv[seg][e] << 16); pf_[2 * e + 1] = __uint_as_float(prv[seg][e] & 0xffff0000u); } \
        } else { \
          _Pragma("unroll") for (int e = 0; e < 8; ++e) pf_[e] = carry[seg * 64 + sub * 8 + e]; } \
        float mv[8]; \
        _Pragma("unroll") for (int e = 0; e < 8; ++e) mv[e] = cf[e] + (pf_[e] - cf[e]) * c_mu[seg][e]; \
        if (seg == 0) { for (int e = 0; e < 8; ++e) R[tA * 64 + sub * 8 + e] = mv[e]; } \
        else if (seg == 1) { for (int e = 0; e < 8; ++e) Kp[tA * 64 + sub * 8 + e] = mv[e]; } \
        else if (seg == 2) { for (int e = 0; e < 8; ++e) V[tA * 64 + sub * 8 + e] = mv[e]; } \
        else if (seg == 3) { for (int e = 0; e < 8; ++e) { float ex = __expf(2.f * mv[e]); Awd[tA * 72 + sub * 8 + e] = f2bf(1.f - 2.f * __builtin_amdgcn_rcpf(ex + 1.f)); } } \
        else { for (int e = 0; e < 8; ++e) Aad[tA * 72 + sub * 8 + e] = f2bf(mv[e]); } } \
      asm volatile("s_waitcnt lgkmcnt(0)" ::: "memory"); \
      {   \
        const int l15 = lane & 15, lg = lane >> 4; \
        f32x4 accB[2][4]; \
        _Pragma("unroll") for (int mt = 0; mt < 2; ++mt) { \
          const u16* As = mt == 0 ? Awd : Aad; \
          const bf16x8 af0 = *(const bf16x8*)(As + (pw * 8 + (l15 & 7)) * 72 + 8 * lg); \
          const bf16x8 af1 = *(const bf16x8*)(As + (pw * 8 + (l15 & 7)) * 72 + 8 * lg + 32); \
          _Pragma("unroll") for (int nt = 0; nt < 4; ++nt) { \
            const char* wp = WL + mt * 9216 + (16 * nt + l15) * 144 + 16 * lg; \
            f32x4 acc = {0.f, 0.f, 0.f, 0.f}; \
            acc = __builtin_amdgcn_mfma_f32_16x16x32_bf16(af0, *(const bf16x8*)wp, acc, 0, 0, 0); \
            accB[mt][nt] = __builtin_amdgcn_mfma_f32_16x16x32_bf16(af1, *(const bf16x8*)(wp + 64), acc, 0, 0, 0); } } \
        {   \
          const bool hb = lg >= 2; \
          _Pragma("unroll") for (int q2 = 0; q2 < 2; ++q2) { \
            const int n = 16 * ((hb ? 2 : 0) + q2) + l15; \
            _Pragma("unroll") for (int j = 0; j < 4; ++j) { \
              const int t = pw * 8 + 4 * (lg & 1) + j; \
              const float x0 = hb ? accB[0][2 + q2][j] : accB[0][q2][j]; \
              const float x1 = hb ? accB[1][2 + q2][j] : accB[1][q2][j]; \
                \
              const float sg = __builtin_amdgcn_rcpf(1.f + __expf(-(c_w0[q2] + x0))); \
              W[t * 64 + n] = __expf(-0.60653066f * sg); \
              B[t * 64 + n] = __builtin_amdgcn_rcpf(1.f + __expf(-(c_a0[q2] + x1))); } } } } \
      asm volatile("s_waitcnt lgkmcnt(0)" ::: "memory"); \
      {   \
        float kkv[8], lr[8], kr[8]; float ssq = 0.f; \
        _Pragma("unroll") for (int e = 0; e < 8; ++e) { int j = sub * 8 + e; kr[e] = Kp[tA * 64 + j]; lr[e] = B[tA * 64 + j]; kkv[e] = kr[e] * c_kk[e]; ssq += kkv[e] * kkv[e]; } \
        ssq = DPP_ADD(ssq, 0xB1); ssq = DPP_ADD(ssq, 0x4E); ssq = DPP_ADD(ssq, 0x141); \
        float inv = __builtin_amdgcn_rsqf(fmaxf(ssq, 1e-24f)); \
        float bs = 0.f, s_br = 0.f, s_kr = 0.f; float an[8], wrn[8]; \
        _Pragma("unroll") for (int e = 0; e < 8; ++e) { int j = sub * 8 + e; \
          float kn = kkv[e] * inv; float bb = kn * lr[e]; float k2 = kr[e] * (1.f + (lr[e] - 1.f) * c_ka[e]); float rr = R[tA * 64 + j]; \
          an[e] = -kn; B[tA * 64 + j] = bb; Kp[tA * 64 + j] = k2; wrn[e] = rr * W[tA * 64 + j]; \
          bs += rr * k2 * c_rk[e]; s_br += bb * rr; s_kr += k2 * rr; } \
        { u32x4 pa = {cvtpk(an[0], an[1]), cvtpk(an[2], an[3]), cvtpk(an[4], an[5]), cvtpk(an[6], an[7])}; \
          u32x4 pw_ = {cvtpk(wrn[0], wrn[1]), cvtpk(wrn[2], wrn[3]), cvtpk(wrn[4], wrn[5]), cvtpk(wrn[6], wrn[7])}; \
          *(u32x4*)(set + 8192 + tA * 128 + sub * 16) = pa; *(u32x4*)(set + 12288 + tA * 128 + sub * 16) = pw_; } \
        bs = DPP_ADD(bs, 0xB1); bs = DPP_ADD(bs, 0x4E); bs = DPP_ADD(bs, 0x141); \
        s_br = DPP_ADD(s_br, 0xB1); s_br = DPP_ADD(s_br, 0x4E); s_br = DPP_ADD(s_br, 0x141); \
        s_kr = DPP_ADD(s_kr, 0xB1); s_kr = DPP_ADD(s_kr, 0x4E); s_kr = DPP_ADD(s_kr, 0x141); \
        bonus[tA] = bs; BRKR[tA] = make_float2(s_br, s_kr); } } while (0)
#define PREP_E(ch_) do { \
      const char* set = smem + ((ch_) & 1) * SETB; \
      const float* V = (const float*)(set + 40960); const float* Y = (const float*)(set + 49152); const float* bonus = (const float*)(set + 57344); \
      float yv[8]; float s1 = 0.f; \
      _Pragma("unroll") for (int e = 0; e < 8; ++e) { yv[e] = Y[tA * 64 + sub * 8 + e]; s1 += yv[e]; } \
      s1 = DPP_ADD(s1, 0xB1); s1 = DPP_ADD(s1, 0x4E); s1 = DPP_ADD(s1, 0x141); \
      float mean = s1 * (1.f / 64.f); float s2 = 0.f; \
      _Pragma("unroll") for (int e = 0; e < 8; ++e) { float d = yv[e] - mean; s2 += d * d; } \
      s2 = DPP_ADD(s2, 0xB1); s2 = DPP_ADD(s2, 0x4E); s2 = DPP_ADD(s2, 0x141); \
      float rstd = rsqrtf(s2 * (1.f / 64.f) + 64e-5f); \
      float bn = bonus[tA]; float gv[8], ov[8]; \
      _Pragma("unroll") for (int e = 0; e < 4; ++e) { gv[2 * e] = __uint_as_float(gg[e] << 16); gv[2 * e + 1] = __uint_as_float(gg[e] & 0xffff0000u); } \
      _Pragma("unroll") for (int e = 0; e < 8; ++e) { int i = sub * 8 + e; \
        float yy = (yv[e] - mean) * rstd * cst[640 + i] + cst[704 + i] + bn * V[tA * 64 + i]; ov[e] = yy * silu(gv[e]); } \
      u32x4 ow = {cvtpk(ov[0], ov[1]), cvtpk(ov[2], ov[3]), cvtpk(ov[4], ov[5]), cvtpk(ov[6], ov[7])}; \
      *(u32x4*)(PS + (row0 + (size_t)(ch_) * 32 + tA) * 3200 + h * 64 + sub * 8) = ow; } while (0)
#define LOAD_GG(ch_) gg = *(const u32x4*)(GB + (row0 + (size_t)(ch_) * 32 + tA) * 1024 + h * 64 + sub * 8)

    PREFETCH(0);
    PREP_ABC(0);
    if (nch > 1) PREFETCH(1);
    __syncthreads();
#pragma unroll 1
    for (int k = 0; k < nch; ++k) {
      if (k >= 1) PREP_E(k - 1);
      LOAD_GG(k);
      if (k + 1 < nch) {
        PREP_ABC(k + 1);
        if (k + 2 < nch) PREFETCH(k + 2);
      }
      asm volatile("s_waitcnt lgkmcnt(0)" ::: "memory");
      __builtin_amdgcn_s_barrier();
      asm volatile("" ::: "memory");
    }
    PREP_E(nch - 1);
#undef PREFETCH
#undef PS_COL
#undef PREP_ABC
#undef PREP_E
#undef LOAD_GG
  }
  __syncthreads();
}

DI void phase2(const Params& p, char* smem, const int g_wave) {
  __shared__ int s_item;
  __shared__ float s_lam;
  const int wid = g_wave;
  float lam;
  {
    const int lane = (int)__builtin_amdgcn_mbcnt_hi(~0u, __builtin_amdgcn_mbcnt_lo(~0u, 0u));
    float a = p.lq1[lane] * p.lk1[lane], b = p.lq2[lane] * p.lk2[lane];
    a = wave_sum(a); b = wave_sum(b);
    lam = __expf(a) - __expf(b) + 0.2f;
    if (lane == 0 && g_wave == 0) s_lam = lam;
  }
  int* ctr = (int*)(p.ws + WS_CTR);
  constexpr int N0 = 128, N1 = N0 + 2048, N2 = N1 + 128, N3 = N2 + 64;
  for (;;) {
    { LAUNDER_TID(tq); if (tq == 0) s_item = atomicAdd(ctr, 1); }
    __syncthreads();
    const int it = __builtin_amdgcn_readfirstlane(s_item);
    __syncthreads();
    if (it >= N3) break;
    const bool is_scan = it < N0 || (it >= N1 && it < N2);
    if (is_scan) {
#ifndef NOSCAN
      const bool prm = it < N0; const int c = prm ? it : it - N1;
      scan_item(p, smem, c >> 4, c & 15, prm, g_wave);
#endif
    } else {
#ifndef NOATT
      const bool prm = it < N1;
      int qb, bh;
      if (prm) { int a = it - N0; qb = 31 - (a >> 6); bh = a & 63; } else { qb = 0; bh = it - N2; }
      const int b = bh >> 3, h = bh & 7;
      const size_t rowq = prm ? (size_t)b * 8192 + qb * 256 : (size_t)TP + b * 64;
      u16* qbase = (u16*)(p.ws + WS_Q) + rowq * 1024 + h * 128;
      const u16* gabase = (const u16*)(p.out + O_Y) + rowq * 1024 + h * 128;
      const u16* kbase = prm ? (const u16*)(p.ws + WS_K) + (size_t)b * 8192 * 1024 + h * 128 : (const u16*)(p.ws + WS_KC) + (size_t)b * 1088 * 1024 + h * 128;
      const u16* vtbase = prm ? (const u16*)(p.ws + WS_VT) + (size_t)bh * 128 * 8192 : (const u16*)(p.ws + WS_VTS) + (size_t)bh * 128 * 1088;
      const int tkv = prm ? 8192 : 1088, nkt = prm ? 4 * (qb + 1) : 17;
      const int mylimit = prm ? 4 * qb + (wid >> 1) + 1 : (wid < 2 ? 17 : 0);
      attn_item(p, smem, qbase, gabase, kbase, vtbase, tkv, nkt, mylimit, &s_lam, g_wave);
#endif
    }
  }
}

DI void phase4(const Params& p, const int g_wave) {
  LAUNDER_TID(tid);
  const int lane = tid & 63, wid = tid >> 6;
  const int gw = blockIdx.x * 8 + wid, nw = gridDim.x * 8;
  float* Y = p.out + O_Y;
  for (int row = gw; row < TT; row += nw) {
    const float* x = row < TP ? p.x_prompt + (size_t)row * 1024 : p.x_sample + (size_t)(row - TP) * 1024;
    float4* yr = (float4*)(Y + (size_t)row * 1024);
    float4 v[4]; float ss = 0.f;
    for (int i = 0; i < 4; ++i) { v[i] = yr[lane + 64 * i]; ss += v[i].x * v[i].x + v[i].y * v[i].y + v[i].z * v[i].z + v[i].w * v[i].w; }
    ss = wave_sum(ss);
    float sc = rsqrtf(ss * (1.f / 1024.f) + 1e-6f);
    for (int i = 0; i < 4; ++i) {
      float4 g = ((const float4*)p.norm_post)[lane + 64 * i];
      float4 xv = ((const float4*)x)[lane + 64 * i];
      float4 o = make_float4(xv.x + v[i].x * sc * g.x, xv.y + v[i].y * sc * g.y, xv.z + v[i].z * sc * g.z, xv.w + v[i].w * sc * g.w);
      yr[lane + 64 * i] = o;
    }
  }
}

__global__ void __launch_bounds__(512) mega(Params p) {
  extern __shared__ __attribute__((aligned(16))) char smem[];
  cg::grid_group grid = cg::this_grid();
  const int lo = (int)p.ph_lo, hi = (int)p.ph_hi;
  const int g_wave = __builtin_amdgcn_readfirstlane(threadIdx.x >> 6);
  if (lo <= 0 && hi > 0) { phase0(p, smem, g_wave); if (hi > 1) grid.sync(); }
  if (lo <= 1 && hi > 1) { phase1(p, smem, g_wave); if (hi > 2) grid.sync(); }
  if (lo <= 2 && hi > 2) { phase2(p, smem, g_wave); if (hi > 3) grid.sync(); }
  if (lo <= 3 && hi > 3) { phase3(p, smem, g_wave); if (hi > 4) grid.sync(); }
  if (lo <= 4 && hi > 4) { phase4(p, g_wave); }
}

extern "C" void kernel_launch(void* const* d_in, const int* in_sizes, int n_in, void* d_out, int out_size, void* d_ws, size_t ws_size, hipStream_t stream) {
  static int grid_blocks = 0;
  if (!grid_blocks) {
    int dev = 0, cus = 0, per_cu = 0;
    hipGetDevice(&dev);
    hipDeviceGetAttribute(&cus, hipDeviceAttributeMultiprocessorCount, dev);
    hipFuncSetAttribute((const void*)mega, hipFuncAttributeMaxDynamicSharedMemorySize, LDS_BYTES);
    hipOccupancyMaxActiveBlocksPerMultiprocessor(&per_cu, (const void*)mega, 512, LDS_BYTES);
    if (per_cu < 1) per_cu = 1;
    if (per_cu > 1) per_cu = 1;
    grid_blocks = cus * per_cu;
    if (ws_size < WS_TOTAL) fprintf(stderr, "workspace too small: %zu < %zu\n", ws_size, (size_t)WS_END);
  }
  Params p{};
  const float** pp = (const float**)&p;
  for (int i = 0; i < 25; ++i) pp[i] = (const float*)d_in[i];
  p.out = (float*)d_out; p.ws = (char*)d_ws;
#if NLAUNCH == 1
  p.ph_lo = 0; p.ph_hi = 5;
  void* args[] = {&p};
  hipError_t e = hipLaunchCooperativeKernel((const void*)mega, dim3(grid_blocks), dim3(512), args, LDS_BYTES, stream);
  if (e != hipSuccess) fprintf(stderr, "cooperative launch failed: %s (grid %d)\n", hipGetErrorString(e), grid_blocks);
#else
  for (int ph = 0; ph < 5; ++ph) {
    p.ph_lo = ph; p.ph_hi = ph + 1;
    hipLaunchKernelGGL(mega, dim3(grid_blocks), dim3(512), LDS_BYTES, stream, p);
  }
#endif
}
```
